# Optimizing an MI355X kernel written in HIP

```python
import math
import jax, jax.numpy as jnp
from jax import lax
import numpy as np

D_MODEL = 1024
BATCH = 4
SEQ = 4096
DEPTH = 2

H_A = 8
DQK_A = D_MODEL // 16
DV_A = D_MODEL // 8
QK_A = H_A * DQK_A
V_A = H_A * DV_A
CHUNK = 64
CONV_K = 4
H_B = 8
HD_B = D_MODEL // 8
W_B = H_B * HD_B
QBLK = 128
D_FF = 4 * D_MODEL
EPS = 1e-6
IN_SIZES = (QK_A, QK_A, V_A, V_A, H_A, H_A, W_B, W_B, W_B, D_MODEL, D_MODEL)
IN_COLS = sum(IN_SIZES)

kernel_name = "hybrid_mlstm_stickbreaking_block"


def rms_norm(x, g):
    xf = x.astype(jnp.float32)
    y = xf * lax.rsqrt(jnp.mean(xf * xf, axis=-1, keepdims=True) + EPS)
    return (y * g.astype(jnp.float32)).astype(x.dtype)


def head_rms_norm(x, g):
    xf = x.astype(jnp.float32)
    y = xf * lax.rsqrt(jnp.mean(xf * xf, axis=-1, keepdims=True) + EPS)
    return y * g.astype(jnp.float32)


def causal_conv(x, w):
    S = x.shape[1]
    xp = jnp.pad(x, ((0, 0), (CONV_K - 1, 0), (0, 0)))
    y = xp[:, 0:S] * w[0]
    for j in range(1, CONV_K):
        y = y + xp[:, j:j + S] * w[j]
    return y


def mlstm_chunkwise(q, k, v, i_pre, f_pre):
    B, S, H, _ = q.shape
    NC = S // CHUNK
    to_chunks = lambda a: jnp.moveaxis(a.astype(jnp.float32).reshape(B, NC, CHUNK, H, -1), 3, 1)
    q = to_chunks(q)
    k = to_chunks(k) * (DQK_A ** -0.5)
    v = to_chunks(v)
    gate = lambda a: jnp.moveaxis(a.astype(jnp.float32).reshape(B, NC, CHUNK, H), 3, 1)
    logf = jax.nn.log_sigmoid(gate(f_pre))
    ig = gate(i_pre)
    b = jnp.cumsum(logf, axis=-1)
    b_last = b[..., -1]

    a = b_last[..., None] - b + ig
    m_loc = jnp.max(a, axis=-1)
    w = jnp.exp(a - m_loc[..., None])
    S_loc = jnp.einsum('bhcs,bhcsk,bhcsv->bhckv', w, k, v)
    n_loc = jnp.einsum('bhcs,bhcsk->bhck', w, k)

    def step(carry, inp):
        S_prev, n_prev, m_prev = carry
        S_l, n_l, m_l, bl = inp
        m_new = jnp.maximum(bl + m_prev, m_l)
        sp = jnp.exp(bl + m_prev - m_new)
        sl = jnp.exp(m_l - m_new)
        S_new = sp[..., None, None] * S_prev + sl[..., None, None] * S_l
        n_new = sp[..., None] * n_prev + sl[..., None] * n_l
        return (S_new, n_new, m_new), (S_prev, n_prev, m_prev)

    init = (jnp.zeros_like(S_loc[:, :, 0]), jnp.zeros_like(n_loc[:, :, 0]), jnp.zeros_like(m_loc[:, :, 0]))
    xs = (jnp.moveaxis(S_loc, 2, 0), jnp.moveaxis(n_loc, 2, 0), jnp.moveaxis(m_loc, 2, 0), jnp.moveaxis(b_last, 2, 0))
    _, (S0, n0, m0) = lax.scan(step, init, xs)
    S0 = jnp.moveaxis(S0, 0, 2)
    n0 = jnp.moveaxis(n0, 0, 2)
    m0 = jnp.moveaxis(m0, 0, 2)

    causal = jnp.tril(jnp.ones((CHUNK, CHUNK), dtype=bool))
    D = jnp.where(causal, b[..., :, None] - b[..., None, :] + ig[..., None, :], -jnp.inf)
    b_inter = b + m0[..., None]
    m_t = jnp.maximum(b_inter, jnp.max(D, axis=-1))
    P = jnp.exp(D - m_t[..., None]) * jnp.einsum('bhctk,bhcsk->bhcts', q, k)
    inter = jnp.exp(b_inter - m_t)
    num = jnp.einsum('bhcts,bhcsv->bhctv', P, v) + inter[..., None] * jnp.einsum('bhctk,bhckv->bhctv', q, S0)
    den = jnp.sum(P, axis=-1) + inter * jnp.einsum('bhctk,bhck->bhct', q, n0)
    h = num / jnp.maximum(jnp.abs(den), jnp.exp(-m_t))[..., None]
    return jnp.moveaxis(h, 1, 3).reshape(B, S, H, DV_A)


def stick_breaking(q, k, v):
    S = q.shape[1]
    scale = HD_B ** -0.5
    outs = []
    for blk in range(S // QBLK):
        t0, t1 = blk * QBLK, (blk + 1) * QBLK
        z = jnp.einsum('bqhd,bshd->bhqs', q[:, t0:t1], k[:, :t1]) * scale
        t_idx = t0 + jnp.arange(QBLK)
        s_idx = jnp.arange(t1)
        strict = s_idx[None, :] < t_idx[:, None]
        log_keep = jnp.where(strict, jax.nn.log_sigmoid(-z), 0.0)
        suffix = lax.cumsum(log_keep, axis=3, reverse=True) - log_keep
        A = jnp.where(strict, jnp.exp(jax.nn.log_sigmoid(z) + suffix), 0.0)
        outs.append(jnp.einsum('bhqs,bshd->bqhd', A, v[:, :t1]))
    return jnp.concatenate(outs, axis=1)


def setup_inputs(seed: int = 0) -> dict:
    key = jax.random.key(seed)
    ks = jax.random.split(key, 15)
    n = jax.random.normal
    f32 = jnp.float32
    x = n(ks[0], (BATCH, SEQ, D_MODEL), f32)
    norm_mix_g = 1.0 + 0.1 * n(ks[1], (DEPTH, D_MODEL), f32)
    w_in = n(ks[2], (DEPTH, D_MODEL, IN_COLS), f32) * D_MODEL ** -0.5
    b_if = jnp.concatenate([0.5 * n(ks[3], (DEPTH, H_A), f32),
                            3.0 + 0.5 * n(ks[4], (DEPTH, H_A), f32)], axis=-1)
    b_gate = 0.02 * n(ks[5], (DEPTH, 2 * D_MODEL), f32)
    conv_w = n(ks[6], (DEPTH, CONV_K, 2 * QK_A), f32) * CONV_K ** -0.5
    mlstm_norm_g = 1.0 + 0.1 * n(ks[7], (DEPTH, V_A), f32)
    sb_q_norm_g = 1.0 + 0.1 * n(ks[8], (DEPTH, HD_B), f32)
    sb_k_norm_g = 1.0 + 0.1 * n(ks[9], (DEPTH, HD_B), f32)
    w_out = n(ks[10], (DEPTH, D_MODEL, D_MODEL), f32) * D_MODEL ** -0.5
    norm_mlp_g = 1.0 + 0.1 * n(ks[11], (DEPTH, D_MODEL), f32)
    w_up = n(ks[12], (DEPTH, D_MODEL, D_FF), f32) * D_MODEL ** -0.5
    w_down = n(ks[13], (DEPTH, D_FF, D_MODEL), f32) * D_FF ** -0.5
    return {"x": x, "norm_mix_g": norm_mix_g, "w_in": w_in, "b_if": b_if, "b_gate": b_gate,
            "conv_w": conv_w, "mlstm_norm_g": mlstm_norm_g, "sb_q_norm_g": sb_q_norm_g,
            "sb_k_norm_g": sb_k_norm_g, "w_out": w_out, "norm_mlp_g": norm_mlp_g,
            "w_up": w_up, "w_down": w_down}


def reference(x, norm_mix_g, w_in, b_if, b_gate, conv_w, mlstm_norm_g, sb_q_norm_g, sb_k_norm_g,
              w_out, norm_mlp_g, w_up, w_down):
    B, S, _ = x.shape
    split_idx = np.cumsum(IN_SIZES)[:-1].tolist()
    for l in range(DEPTH):
        h = rms_norm(x, norm_mix_g[l])
        p = h @ w_in[l]
        q_a, k_a, v_a, o_a, i_a, f_a, q_b, k_b, v_b, g_a, g_b = jnp.split(p, split_idx, axis=-1)
        qk_a = jax.nn.silu(causal_conv(jnp.concatenate([q_a, k_a], axis=-1), conv_w[l]))
        q_a, k_a = qk_a[..., :QK_A], qk_a[..., QK_A:]
        i_pre = i_a.astype(jnp.float32) + b_if[l, :H_A].astype(jnp.float32)
        f_pre = f_a.astype(jnp.float32) + b_if[l, H_A:].astype(jnp.float32)
        h_a = mlstm_chunkwise(q_a.reshape(B, S, H_A, DQK_A), k_a.reshape(B, S, H_A, DQK_A),
                              v_a.reshape(B, S, H_A, DV_A), i_pre, f_pre)
        h_a = head_rms_norm(h_a, mlstm_norm_g[l].reshape(H_A, DV_A)).reshape(B, S, V_A)
        y_a = jax.nn.sigmoid(o_a.astype(jnp.float32)) * h_a
        qn = head_rms_norm(q_b.reshape(B, S, H_B, HD_B), sb_q_norm_g[l])
        kn = head_rms_norm(k_b.reshape(B, S, H_B, HD_B), sb_k_norm_g[l])
        y_b = stick_breaking(qn, kn, v_b.reshape(B, S, H_B, HD_B).astype(jnp.float32)).reshape(B, S, W_B)
        gates = jax.nn.sigmoid(jnp.concatenate([g_a, g_b], axis=-1).astype(jnp.float32)
                               + b_gate[l].astype(jnp.float32))
        y = gates[..., :D_MODEL] * y_a + gates[..., D_MODEL:] * y_b
        x = x + y.astype(x.dtype) @ w_out[l]
        h2 = rms_norm(x, norm_mlp_g[l])
        x = x + jnp.square(jax.nn.relu(h2 @ w_up[l])) @ w_down[l]
    return x
```

```cpp
#include <hip/hip_runtime.h>
#include <hip/hip_cooperative_groups.h>
#include <cstdio>
#include <cstdint>
namespace cg = cooperative_groups;
namespace pg8 {
#define PG8_LAS __attribute__((address_space(3)))
typedef unsigned short bf16_t;
typedef short bf16x8 __attribute__((ext_vector_type(8)));
typedef float f32x4 __attribute__((ext_vector_type(4)));
typedef unsigned u32x4 __attribute__((ext_vector_type(4)));
constexpr int BM = 256, BK = 64, HALF = 128, HTB = HALF * BK * 2  , STAGE_BYTES = 8 * HTB, NXCD = 8, WGM = 4  ;

__host__ __device__ __forceinline__ int lds_byte(int r, int c) { const int st = (r >> 4) * 2 + (c >> 5), rr = r & 15, cc = c & 31, ob = rr * 64 + cc * 2; return st * 1024 + (ob ^ (((ob >> 9) & 1) << 5)); }
__host__ __device__ __forceinline__ void stage_rc(int b, int& R, int& C) { const int st = b / 1024, sb = b % 1024, swz = sb ^ (((sb >> 9) & 1) << 5); R = (st >> 1) * 16 + swz / 64; C = (st & 1) * 32 + (swz % 64) / 2; }
__host__ __device__ __forceinline__ int perm32(int rho) { const int n = rho >> 4, i = rho & 15; return 8 * (i >> 2) + 4 * n + (i & 3); }

struct Unit { int pm, pn; };
struct Gemm { const bf16_t* A; const bf16_t* Bt; int M, N, K; };

struct StaticOrder {
    int nM, nN, nwg, G, c;
    __host__ __device__ void init(int M, int N, int G_, int c_) { nM = M / BM; nN = N / BM; nwg = nM * nN; G = G_; c = c_; }
    __host__ __device__ bool next(int i, Unit& u) const {
        const long L = (long)i * G + c; if (L >= nwg) return false;
        int wgid = (int)L; { const int q = nwg / NXCD, r = nwg % NXCD, xcd = wgid % NXCD, off = wgid / NXCD; wgid = (xcd < r ? xcd * (q + 1) : r * (q + 1) + (xcd - r) * q) + off; }
        const int nig = WGM * nN, gid = wgid / nig, fm = gid * WGM, gsz = (nM - fm) < WGM ? (nM - fm) : WGM;
        u.pm = fm + ((wgid % nig) % gsz); u.pn = (wgid % nig) / gsz; return true;
    }
    __device__ __forceinline__ void a_ready(const Unit&) const {}
    __device__ __forceinline__ void done(const Unit&) const {}
};

__device__ __forceinline__ unsigned cvt_pk_bf16(float lo, float hi) { unsigned r; asm volatile("v_cvt_pk_bf16_f32 %0, %1, %2" : "=v"(r) : "v"(lo), "v"(hi)); return r; }
typedef float f32x2 __attribute__((ext_vector_type(2)));
__device__ __forceinline__ void st16_wt(void* p, u32x4 v) { *(u32x4*)p = v; }
__device__ __forceinline__ void st16_wt_f(void* p, f32x4 v) { *(f32x4*)p = v; }
__device__ __forceinline__ bf16_t f2bf1(float f) { unsigned u = __builtin_bit_cast(unsigned, f); return (bf16_t)((u + 0x7fffu + ((u >> 16) & 1u)) >> 16); }
struct EpiInProj {
    static constexpr bool PERM = true, AFTER_DRAIN = false;
    bf16_t* P; bf16_t* VtA; bf16_t* VtB; bf16_t* Kf; float* rk2  ; const float* rstd;
    PG8_LAS unsigned char* ldx;
    __device__ __forceinline__ void operator()(const f32x4 (&acc)[2][2][4][2], const Unit& u, int wr, int wc, int fr, int fq) const {
        const int pn = u.pn; const int row0 = u.pm * BM + wr * 64 + fr;
        float rsv[2][4];
#pragma unroll
        for (int ai = 0; ai < 2; ++ai)
#pragma unroll
            for (int m = 0; m < 4; ++m) rsv[ai][m] = rstd[row0 + ai * HALF + m * 16];
        const bool isv = (pn >= 4 && pn < 8) || (pn >= 20 && pn < 24);
        const bool isk = (pn >= 16 && pn < 20);
        if (isk) {
#pragma unroll
            for (int ai = 0; ai < 2; ++ai)
#pragma unroll
                for (int m = 0; m < 4; ++m) { const int r = row0 + ai * HALF + m * 16; const int bl = r >> 12, s = r & 4095; const float rs = rsv[ai][m];
#pragma unroll
                    for (int bj = 0; bj < 2; ++bj) { const f32x4 v0 = acc[ai][bj][m][0] * rs, v1 = acc[ai][bj][m][1] * rs;
                        u32x4 w; w.x = cvt_pk_bf16(v0[0], v0[1]); w.y = cvt_pk_bf16(v0[2], v0[3]); w.z = cvt_pk_bf16(v1[0], v1[1]); w.w = cvt_pk_bf16(v1[2], v1[3]);
                        const int hh = (pn - 16) * 2 + bj, st = wc * 2 + (fq >> 1), hi = fq & 1;
                        { const int lane_ = fq * 16 + fr; float p = ((v0[0] * v0[0] + v0[1] * v0[1]) + (v0[2] * v0[2] + v0[3] * v0[3])) + ((v1[0] * v1[0] + v1[1] * v1[1]) + (v1[2] * v1[2] + v1[3] * v1[3]));
                          p += __builtin_bit_cast(float, __builtin_amdgcn_ds_bpermute((lane_ ^ 16) << 2, __builtin_bit_cast(int, p)));
                          p += __builtin_bit_cast(float, __builtin_amdgcn_ds_bpermute((lane_ ^ 32) << 2, __builtin_bit_cast(int, p)));
                          if (fq == 0) unsafeAtomicAdd(rk2 + (size_t)(bl * 8 + hh) * 4096 + s, p); }
                        st16_wt(Kf + ((size_t)(((bl * 8 + hh) * 128 + (s >> 5)) * 8 + st)) * 512 + (s & 31) * 16 + hi * 8, w); } }
        } else if (!isv) {
            const int colt = pn < 4 ? pn * 256 : pn < 12 ? (pn - 8) * 256 + 1024 : pn < 16 ? (pn - 12) * 256 + 2048 : (pn - 24) * 256 + 3072;
            const int col0 = colt + wc * 32 + 8 * fq;
#pragma unroll
            for (int ai = 0; ai < 2; ++ai)
#pragma unroll
                for (int m = 0; m < 4; ++m) { bf16_t* rowp = P + (size_t)(row0 + ai * HALF + m * 16) * 5120 + col0; const float rs = rsv[ai][m];
#pragma unroll
                    for (int bj = 0; bj < 2; ++bj) { const f32x4 v0 = acc[ai][bj][m][0] * rs, v1 = acc[ai][bj][m][1] * rs;
                        u32x4 w; w.x = cvt_pk_bf16(v0[0], v0[1]); w.y = cvt_pk_bf16(v0[2], v0[3]); w.z = cvt_pk_bf16(v1[0], v1[1]); w.w = cvt_pk_bf16(v1[2], v1[3]);
                        st16_wt(rowp + bj * HALF, w); } }
        } else {
            bf16_t* Vt = pn < 8 ? VtA : VtB;
            const int hb = (pn < 8 ? pn - 4 : pn - 20) * 2;
            const int lane_ = fq * 16 + fr;
            PG8_LAS bf16_t* tl = (PG8_LAS bf16_t*)(ldx + (wr * 4 + wc) * 2048);
            const int pk = ((fr >> 2) & 1) * 8 + ((fr >> 3) & 1) * 4 + (fr & 3);
#pragma unroll
            for (int ai = 0; ai < 2; ++ai)
#pragma unroll
                for (int m = 0; m < 4; ++m) { const int r0 = u.pm * BM + wr * 64 + ai * HALF + m * 16; const int bl = r0 >> 12, s0 = r0 & 4095; const float rs = rsv[ai][m];
#pragma unroll
                    for (int bj = 0; bj < 2; ++bj) {
#pragma unroll
                        for (int n = 0; n < 2; ++n)
#pragma unroll
                            for (int e = 0; e < 4; ++e) tl[(8 * fq + 4 * n + e) * 16 + pk] = f2bf1(acc[ai][bj][m][n][e] * rs);
                        asm volatile("s_waitcnt lgkmcnt(0)" ::: "memory");
                        const u32x4 v = *(const PG8_LAS u32x4*)(tl + lane_ * 8);
                        asm volatile("s_waitcnt lgkmcnt(0)" ::: "memory");
                        *(u32x4*)(Vt + ((size_t)(((bl * 8 + hb + bj) * 128 + (s0 >> 5)) * 8 + wc * 2 + ((s0 >> 4) & 1))) * 512 + lane_ * 8) = v; } }
        }
    }
};
struct EpiRelu2 {
    static constexpr bool PERM = true, AFTER_DRAIN = false;
    bf16_t* O; int ldc;
    __device__ __forceinline__ void operator()(const f32x4 (&acc)[2][2][4][2], const Unit& u, int wr, int wc, int fr, int fq) const {
        const int row0 = u.pm * BM + wr * 64 + fr; const int col0 = u.pn * BM + wc * 32 + 8 * fq;
#pragma unroll
        for (int ai = 0; ai < 2; ++ai)
#pragma unroll
            for (int m = 0; m < 4; ++m) { bf16_t* rowp = O + (size_t)(row0 + ai * HALF + m * 16) * ldc + col0;
#pragma unroll
                for (int bj = 0; bj < 2; ++bj) { f32x4 v0 = acc[ai][bj][m][0], v1 = acc[ai][bj][m][1];
#pragma unroll
                    for (int e = 0; e < 4; ++e) { const float a = fmaxf(v0[e], 0.f), b = fmaxf(v1[e], 0.f); v0[e] = a * a; v1[e] = b * b; }
                    u32x4 w; w.x = cvt_pk_bf16(v0[0], v0[1]); w.y = cvt_pk_bf16(v0[2], v0[3]); w.z = cvt_pk_bf16(v1[0], v1[1]); w.w = cvt_pk_bf16(v1[2], v1[3]);
                    st16_wt(rowp + bj * HALF, w); } }
    }
};
struct EpiRes {
    static constexpr bool PERM = true, AFTER_DRAIN = false;
    const float* base; float* out; int ldc;
    __device__ __forceinline__ void operator()(const f32x4 (&acc)[2][2][4][2], const Unit& u, int wr, int wc, int fr, int fq) const {
        const int col0 = u.pn * BM + wc * 32 + 8 * fq;
#pragma unroll
        for (int ai = 0; ai < 2; ++ai) {
            f32x4 bs[4][2][2];
#pragma unroll
            for (int m = 0; m < 4; ++m) { const size_t off = (size_t)(u.pm * BM + ai * HALF + wr * 64 + m * 16 + fr) * ldc + col0;
#pragma unroll
                for (int bj = 0; bj < 2; ++bj)
#pragma unroll
                    for (int n = 0; n < 2; ++n) bs[m][bj][n] = *(const f32x4*)(base + off + bj * HALF + n * 4); }
#pragma unroll
            for (int m = 0; m < 4; ++m) { const size_t off = (size_t)(u.pm * BM + ai * HALF + wr * 64 + m * 16 + fr) * ldc + col0;
#pragma unroll
                for (int bj = 0; bj < 2; ++bj)
#pragma unroll
                    for (int n = 0; n < 2; ++n) *(f32x4*)(out + off + bj * HALF + n * 4) = bs[m][bj][n] + acc[ai][bj][m][n]; }
        }
    }
};
struct EpiResProbe {
    static constexpr bool PERM = false, AFTER_DRAIN = false;
    const float* base; float* out; int ldc;
    __device__ __forceinline__ void operator()(const f32x4 (&acc)[2][2][4][2], const Unit& u, int wr, int wc, int fr, int fq) const {
        const int col0 = u.pn * BM + wc * 32 + 4 * fq;
#pragma unroll
        for (int ai = 0; ai < 2; ++ai)
#pragma unroll
            for (int m = 0; m < 4; ++m) { const int r = u.pm * BM + ai * HALF + wr * 64 + m * 16 + fr; const size_t off = (size_t)r * ldc + col0; const size_t off2 = (size_t)(r & 2047) * ldc + col0;
#pragma unroll
                for (int bj = 0; bj < 2; ++bj)
#pragma unroll
                    for (int n = 0; n < 2; ++n) { const f32x4 bs = *(const f32x4*)(base + off + bj * HALF + n * 16); *(f32x4*)(out + off2 + bj * HALF + n * 16) = bs + acc[ai][bj][m][n]; } }
    }
};
struct EpiResNorm {
    static constexpr bool PERM = true, AFTER_DRAIN = false;
    const float* base; float* out; int ldc; bf16_t* An; const float* g; float* rsq;
    __device__ __forceinline__ void operator()(const f32x4 (&acc)[2][2][4][2], const Unit& u, int wr, int wc, int fr, int fq) const {
        const int col0 = u.pn * BM + wc * 32 + 8 * fq; const int lane = fq * 16 + fr;
        f32x4 gv[2][2];
#pragma unroll
        for (int bj = 0; bj < 2; ++bj)
#pragma unroll
            for (int n = 0; n < 2; ++n) gv[bj][n] = *(const f32x4*)(g + col0 + bj * HALF + n * 4);
#pragma unroll
        for (int ai = 0; ai < 2; ++ai) {
            f32x4 bs[4][2][2];
#pragma unroll
            for (int m = 0; m < 4; ++m) { const size_t off = (size_t)(u.pm * BM + ai * HALF + wr * 64 + m * 16 + fr) * ldc + col0;
#pragma unroll
                for (int bj = 0; bj < 2; ++bj)
#pragma unroll
                    for (int n = 0; n < 2; ++n) bs[m][bj][n] = *(const f32x4*)(base + off + bj * HALF + n * 4); }
#pragma unroll
            for (int m = 0; m < 4; ++m) { const int r = u.pm * BM + ai * HALF + wr * 64 + m * 16 + fr; const size_t off = (size_t)r * ldc + col0; float ss = 0.f;
#pragma unroll
                for (int bj = 0; bj < 2; ++bj) { u32x4 pk;
#pragma unroll
                    for (int n = 0; n < 2; ++n) { const f32x4 o = bs[m][bj][n] + acc[ai][bj][m][n];
                        *(f32x4*)(out + off + bj * HALF + n * 4) = o; ss += (o[0] * o[0] + o[1] * o[1]) + (o[2] * o[2] + o[3] * o[3]);
                        const f32x4 w = o * gv[bj][n]; pk[2 * n] = cvt_pk_bf16(w[0], w[1]); pk[2 * n + 1] = cvt_pk_bf16(w[2], w[3]); }
                    *(u32x4*)(An + off + bj * HALF) = pk; }
                ss += __builtin_bit_cast(float, __builtin_amdgcn_ds_bpermute((lane ^ 16) << 2, __builtin_bit_cast(int, ss)));
                ss += __builtin_bit_cast(float, __builtin_amdgcn_ds_bpermute((lane ^ 32) << 2, __builtin_bit_cast(int, ss)));
                if (fq == 0) unsafeAtomicAdd(rsq + r, ss); }
        }
    }
};
struct EpiRelu2N {
    static constexpr bool PERM = true, AFTER_DRAIN = false;
    bf16_t* O; int ldc; const float* rsq; float invk, eps;
    __device__ __forceinline__ void operator()(const f32x4 (&acc)[2][2][4][2], const Unit& u, int wr, int wc, int fr, int fq) const {
        const int row0 = u.pm * BM + wr * 64 + fr; const int col0 = u.pn * BM + wc * 32 + 8 * fq;
        float rq[2][4];
#pragma unroll
        for (int ai = 0; ai < 2; ++ai)
#pragma unroll
            for (int m = 0; m < 4; ++m) rq[ai][m] = rsq[row0 + ai * HALF + m * 16];
#pragma unroll
        for (int ai = 0; ai < 2; ++ai)
#pragma unroll
            for (int m = 0; m < 4; ++m) { const int r = row0 + ai * HALF + m * 16; bf16_t* rowp = O + (size_t)r * ldc + col0;
                const float rstd = 1.0f / sqrtf(rq[ai][m] * invk + eps);
#pragma unroll
                for (int bj = 0; bj < 2; ++bj) { f32x4 v0 = acc[ai][bj][m][0], v1 = acc[ai][bj][m][1];
#pragma unroll
                    for (int e = 0; e < 4; ++e) { const float a = fmaxf(v0[e], 0.f) * rstd, b = fmaxf(v1[e], 0.f) * rstd; v0[e] = a * a; v1[e] = b * b; }
                    u32x4 w; w.x = cvt_pk_bf16(v0[0], v0[1]); w.y = cvt_pk_bf16(v0[2], v0[3]); w.z = cvt_pk_bf16(v1[0], v1[1]); w.w = cvt_pk_bf16(v1[2], v1[3]);
                    st16_wt(rowp + bj * HALF, w); } }
    }
};
template <class Epi, class Sched, bool ALIGN_EPI = false, bool SP2 = false>
__device__ __forceinline__ void gemm_phase(PG8_LAS unsigned char* lds, const Gemm g, const Sched& S, const Epi& E) {
    int tid_ = threadIdx.x; asm volatile("" : "+v"(tid_));
    const int tid = tid_, wid = __builtin_amdgcn_readfirstlane(tid >> 6), lane = tid & 63, wr = wid >> 2, wc = wid & 3, fr = lane & 15, fq = lane >> 4;
    const int K = g.K, nt = K / BK;
    unsigned voffA[2], voffB[2];
#pragma unroll
    for (int i = 0; i < 2; ++i) { int R, C; stage_rc(tid * 16 + i * 8192, R, C); const int Rb = Epi::PERM ? ((R & ~31) + perm32(R & 31)) : R;
        voffA[i] = (unsigned)(R * K + C) * 2u; voffB[i] = (unsigned)(Rb * K + C) * 2u; }
    const size_t kstep = (size_t)(BK * 2);
    const size_t hstep = (size_t)HALF * K * 2;
    const size_t tstep = 2 * hstep;
    const unsigned ldsw = (unsigned)wid * 1024u;
    const int aoff = lds_byte(wr * 64 + fr, fq * 8), boff = lds_byte(wc * 32 + fr, fq * 8);
#define PG8_SA(b, h) (((b) * 2 + (h)) * HTB)
#define PG8_SB(b, h) ((4 + (b) * 2 + (h)) * HTB)
#define PG8_STAGE(bufoff, gbase, voff) do { _Pragma("unroll") for (int _i = 0; _i < 2; ++_i) \
        __builtin_amdgcn_global_load_lds((const unsigned*)((const char*)(gbase) + (voff)[_i]), (PG8_LAS unsigned*)(lds + (bufoff) + ldsw + _i * 8192), 16, 0, 0); } while (0)
#define PG8_LDA(dst, b, h) do { _Pragma("unroll") for (int m = 0; m < 4; ++m) _Pragma("unroll") for (int k = 0; k < 2; ++k) dst[m][k] = *(const PG8_LAS bf16x8*)(lds + PG8_SA(b, h) + aoff + m * 2048 + k * 1024); } while (0)
#define PG8_LDB(dst, b, h) do { _Pragma("unroll") for (int n = 0; n < 2; ++n) _Pragma("unroll") for (int k = 0; k < 2; ++k) dst[n][k] = *(const PG8_LAS bf16x8*)(lds + PG8_SB(b, h) + boff + n * 2048 + k * 1024); } while (0)
#define PG8_MMA(ai, bj, At, Bt) do { __builtin_amdgcn_s_setprio(1); _Pragma("unroll") for (int m = 0; m < 4; ++m) _Pragma("unroll") for (int n = 0; n < 2; ++n) _Pragma("unroll") for (int k = 0; k < 2; ++k) \
        acc[ai][bj][m][n] = __builtin_amdgcn_mfma_f32_16x16x32_bf16(Bt[n][k], At[m][k], acc[ai][bj][m][n], 0, 0, 0); __builtin_amdgcn_s_setprio(0); } while (0)
#define PG8_WAIT_V(n) asm volatile("s_waitcnt vmcnt(" #n ")" ::: "memory")
#define PG8_WAIT_L(n) asm volatile("s_waitcnt lgkmcnt(" #n ")" ::: "memory")
#define PG8_BAR __builtin_amdgcn_s_barrier()
#define PG8_SCHED __builtin_amdgcn_sched_barrier(0)
    Unit cur, nxt; int ui = 0;
    if (!S.next(0, cur)) return;
    f32x4 acc[2][2][4][2];
#pragma unroll
    for (int a = 0; a < 2; ++a)
#pragma unroll
        for (int b = 0; b < 2; ++b)
#pragma unroll
            for (int m = 0; m < 4; ++m)
#pragma unroll
                for (int n = 0; n < 2; ++n) acc[a][b][m][n] = (f32x4){0.f, 0.f, 0.f, 0.f};
    bf16x8 At[4][2], B0[2][2], B1[2][2];
    const char* cA = (const char*)g.A + (size_t)cur.pm * tstep; const char* cB = (const char*)g.Bt + (size_t)cur.pn * tstep;
    S.a_ready(cur);
    if constexpr (SP2) {
        PG8_STAGE(PG8_SB(0, 0), cB, voffB); PG8_STAGE(PG8_SB(0, 1), cB + hstep, voffB); PG8_STAGE(PG8_SA(0, 0), cA, voffA); PG8_STAGE(PG8_SA(0, 1), cA + hstep, voffA);
        if (wr == 1) PG8_BAR;
        PG8_WAIT_V(2); PG8_BAR;
        PG8_STAGE(PG8_SB(1, 0), cB + kstep, voffB); PG8_STAGE(PG8_SA(1, 0), cA + kstep, voffA); PG8_STAGE(PG8_SB(1, 1), cB + hstep + kstep, voffB);
        PG8_WAIT_V(6); PG8_BAR;
    } else {
        PG8_STAGE(PG8_SB(0, 0), cB, voffB); PG8_STAGE(PG8_SA(0, 0), cA, voffA); PG8_STAGE(PG8_SB(0, 1), cB + hstep, voffB); PG8_STAGE(PG8_SA(0, 1), cA + hstep, voffA);
        if (wr == 1) PG8_BAR;
        PG8_WAIT_V(4); PG8_BAR;
        PG8_STAGE(PG8_SB(1, 0), cB + kstep, voffB); PG8_STAGE(PG8_SA(1, 0), cA + kstep, voffA); PG8_STAGE(PG8_SB(1, 1), cB + hstep + kstep, voffB);
        PG8_WAIT_V(6); PG8_BAR;
    }
    for (;;) {
        const bool has_next = S.next(ui + 1, nxt);
        const char* nA = has_next ? (const char*)g.A + (size_t)nxt.pm * tstep : cA; const char* nB = has_next ? (const char*)g.Bt + (size_t)nxt.pn * tstep : cB;
        for (int t = 0; t < nt; t += 2) {
            const bool last = (t == nt - 2);
            const char* a1 = cA + (size_t)(t + 1) * kstep;
            const char* a2 = last ? nA : cA + (size_t)(t + 2) * kstep; const char* b2 = last ? nB : cB + (size_t)(t + 2) * kstep;
            const char* a3 = a2 + kstep; const char* b3 = b2 + kstep;
            if (last && has_next) S.a_ready(nxt);
            if constexpr (SP2) {
            PG8_LDB(B0, 0, 0); PG8_LDB(B1, 0, 1); PG8_SCHED; PG8_LDA(At, 0, 0); PG8_STAGE(PG8_SA(1, 1), a1 + hstep, voffA);
            PG8_WAIT_V(8); PG8_WAIT_L(0); PG8_BAR; PG8_MMA(0, 0, At, B0); PG8_MMA(0, 1, At, B1); PG8_BAR; PG8_SCHED;
            PG8_LDA(At, 0, 1); PG8_STAGE(PG8_SB(0, 0), b2, voffB); PG8_STAGE(PG8_SB(0, 1), b2 + hstep, voffB); PG8_STAGE(PG8_SA(0, 0), a2, voffA);
            PG8_WAIT_V(8); PG8_WAIT_L(0); PG8_BAR; PG8_MMA(1, 0, At, B0); PG8_MMA(1, 1, At, B1); PG8_BAR; PG8_SCHED;
            PG8_LDB(B0, 1, 0); PG8_LDB(B1, 1, 1); PG8_SCHED; PG8_LDA(At, 1, 0); PG8_STAGE(PG8_SA(0, 1), a2 + hstep, voffA);
            PG8_WAIT_V(8); PG8_WAIT_L(0); PG8_BAR; PG8_MMA(0, 0, At, B0); PG8_MMA(0, 1, At, B1); PG8_BAR; PG8_SCHED;
            PG8_LDA(At, 1, 1); PG8_STAGE(PG8_SB(1, 0), b3, voffB); PG8_STAGE(PG8_SB(1, 1), b3 + hstep, voffB); PG8_STAGE(PG8_SA(1, 0), a3, voffA);
            PG8_WAIT_V(8); PG8_WAIT_L(0); PG8_BAR; PG8_MMA(1, 0, At, B0); PG8_MMA(1, 1, At, B1); PG8_BAR; PG8_SCHED;
            } else {
            PG8_LDB(B0, 0, 0); PG8_SCHED; PG8_LDA(At, 0, 0); PG8_STAGE(PG8_SA(1, 1), a1 + hstep, voffA);
            PG8_WAIT_L(8); PG8_BAR; PG8_WAIT_L(0); PG8_MMA(0, 0, At, B0); PG8_BAR; PG8_SCHED;
            PG8_LDB(B1, 0, 1); PG8_STAGE(PG8_SB(0, 0), b2, voffB);
            PG8_BAR; PG8_WAIT_L(0); PG8_MMA(0, 1, At, B1); PG8_BAR;
            PG8_LDA(At, 0, 1); PG8_STAGE(PG8_SA(0, 0), a2, voffA);
            PG8_BAR; PG8_WAIT_L(0); PG8_MMA(1, 0, At, B0); PG8_BAR; PG8_SCHED;
            PG8_STAGE(PG8_SB(0, 1), b2 + hstep, voffB);
            PG8_WAIT_V(6); PG8_BAR; PG8_MMA(1, 1, At, B1); PG8_BAR;
            PG8_LDB(B0, 1, 0); PG8_SCHED; PG8_LDA(At, 1, 0); PG8_STAGE(PG8_SA(0, 1), a2 + hstep, voffA);
            PG8_WAIT_L(8); PG8_BAR; PG8_WAIT_L(0); PG8_MMA(0, 0, At, B0); PG8_BAR; PG8_SCHED;
            PG8_LDB(B1, 1, 1); PG8_STAGE(PG8_SB(1, 0), b3, voffB);
            PG8_BAR; PG8_WAIT_L(0); PG8_MMA(0, 1, At, B1); PG8_BAR;
            PG8_LDA(At, 1, 1); PG8_STAGE(PG8_SA(1, 0), a3, voffA);
            PG8_BAR; PG8_WAIT_L(0); PG8_MMA(1, 0, At, B0); PG8_BAR; PG8_SCHED;
            PG8_STAGE(PG8_SB(1, 1), b3 + hstep, voffB);
            PG8_WAIT_V(6); PG8_BAR; PG8_MMA(1, 1, At, B1); PG8_BAR;
            }
        }
        if constexpr (ALIGN_EPI) { if (wr == 0) PG8_BAR; }
        if constexpr (!Epi::AFTER_DRAIN) { E(acc, cur, wr, wc, fr, fq); S.done(cur); }
        if (!has_next) break;
#pragma unroll
        for (int a = 0; a < 2; ++a)
#pragma unroll
            for (int b = 0; b < 2; ++b)
#pragma unroll
                for (int m = 0; m < 4; ++m)
#pragma unroll
                    for (int n = 0; n < 2; ++n) acc[a][b][m][n] = (f32x4){0.f, 0.f, 0.f, 0.f};
        cur = nxt; cA = nA; cB = nB; ++ui;
        if constexpr (ALIGN_EPI) { if (wr == 1) PG8_BAR; }
    }
    PG8_WAIT_V(0);
    if constexpr (!ALIGN_EPI) { if (wr == 0) PG8_BAR; }
    PG8_BAR;
    if constexpr (Epi::AFTER_DRAIN) { E.fused(acc, cur, wr, wc, fr, fq, lds, wid, lane); S.done(cur); }
#undef PG8_SA
#undef PG8_SB
#undef PG8_STAGE
#undef PG8_LDA
#undef PG8_LDB
#undef PG8_MMA
#undef PG8_WAIT_V
#undef PG8_WAIT_L
#undef PG8_BAR
#undef PG8_SCHED
}
}
#define DI __device__ __forceinline__
#define LAS __attribute__((address_space(3)))
typedef unsigned short bf16;
typedef short bf16x8 __attribute__((ext_vector_type(8)));
typedef short s16x4 __attribute__((ext_vector_type(4)));
typedef float f32x4 __attribute__((ext_vector_type(4)));
typedef float f32x16 __attribute__((ext_vector_type(16)));
typedef unsigned u32x2 __attribute__((ext_vector_type(2)));
typedef unsigned u32x4 __attribute__((ext_vector_type(4)));
typedef float f32x2_t __attribute__((ext_vector_type(2)));
typedef __bf16 bf16x2_t __attribute__((ext_vector_type(2)));

constexpr int NTOK = 16384, DM = 1024, SEQ = 4096, DFF = 4096, INC = 8208, HTOK = 8192, PW = 5120;
constexpr int PC_QA = 0, PC_KA = 512, PC_OA = 1024, PC_QB = 2048, PC_GA = 3072, PC_GB = 4096;
constexpr float EPS = 1e-6f;
constexpr size_t MiB = 1u << 20;
constexpr size_t WS_GATES = 1 * MiB, WS_STATS = 2 * MiB, WS_WIN = 4 * MiB, WS_WOUT = 36 * MiB, WS_WUP = 40 * MiB, WS_WDN = 56 * MiB,
                 WS_XN = 72 * MiB, WS_P = 104 * MiB, WS_KF = 184 * MiB  , WS_VTA = 200 * MiB, WS_VTB = 216 * MiB, WS_SL = 232 * MiB, WS_END = 248 * MiB,
                 WS_HID = 72 * MiB  , WS_AN = 224 * MiB  , WS_TOP = 256 * MiB;
constexpr int LDS_BYTES = 147456 + 64;

DI float bf2f(short b) { return __uint_as_float(((unsigned)(unsigned short)b) << 16); }
DI unsigned pk2(float lo, float hi) { f32x2_t v = {lo, hi}; bf16x2_t b = __builtin_convertvector(v, bf16x2_t); return __builtin_bit_cast(unsigned, b); }
DI bf16x8 pack8(const float* v) { u32x4 p = {pk2(v[0], v[1]), pk2(v[2], v[3]), pk2(v[4], v[5]), pk2(v[6], v[7])}; return __builtin_bit_cast(bf16x8, p); }
DI float shx(float v, int o, int lane) { return __builtin_bit_cast(float, __builtin_amdgcn_ds_bpermute((lane ^ o) << 2, __builtin_bit_cast(int, v))); }
DI float shi(float v, int src) { return __builtin_bit_cast(float, __builtin_amdgcn_ds_bpermute(src << 2, __builtin_bit_cast(int, v))); }
DI float wave_sum(float v, int lane) {
#pragma unroll
    for (int o = 1; o < 64; o <<= 1) v += shx(v, o, lane);
    return v; }
DI float wave_max(float v, int lane) {
#pragma unroll
    for (int o = 1; o < 64; o <<= 1) v = fmaxf(v, shx(v, o, lane));
    return v; }
DI float scan_add(float v, int lane) {
#pragma unroll
    for (int o = 1; o < 64; o <<= 1) { const float t = shi(v, lane >= o ? lane - o : lane); if (lane >= o) v += t; }
    return v; }
DI float scan_max(float v, int lane) {
#pragma unroll
    for (int o = 1; o < 64; o <<= 1) { const float t = shi(v, lane >= o ? lane - o : lane); if (lane >= o) v = fmaxf(v, t); }
    return v; }
#define LDS_FENCE() asm volatile("s_waitcnt lgkmcnt(0)" ::: "memory")
DI float sigm(float x) { return __builtin_amdgcn_rcpf(1.f + __expf(-x)); }
DI float logsigmoid_(float x) { return fminf(x, 0.f) - log1pf(expf(-fabsf(x))); }
DI int crow(int r, int hi) { return (r & 3) + 8 * (r >> 2) + 4 * hi; }
#define MFMA32(a, b, c) __builtin_amdgcn_mfma_f32_32x32x16_bf16((a), (b), (c), 0, 0, 0)

DI void transpose_item(const float* W, int ldw, int srccol0, int k0, bf16* WT, int K, int dstrow0, LAS float* scr, int lane) {
#pragma unroll 16
    for (int i = 0; i < 32; ++i) { const int kk = 2 * i + (lane >> 5); scr[kk * 33 + (lane & 31)] = W[(size_t)(k0 + kk) * ldw + srccol0 + (lane & 31)]; }
    LDS_FENCE();
    const int c = lane & 7;
#pragma unroll
    for (int j = 0; j < 4; ++j) { const int n = (lane >> 3) + 8 * j; const LAS float* s = scr + (8 * c) * 33 + n;
        u32x4 o; o.x = pk2(s[0 * 33], s[1 * 33]); o.y = pk2(s[2 * 33], s[3 * 33]); o.z = pk2(s[4 * 33], s[5 * 33]); o.w = pk2(s[6 * 33], s[7 * 33]);
        *(u32x4*)(WT + (size_t)(dstrow0 + n) * K + k0 + 8 * c) = o; }
    LDS_FENCE();
}
DI void phase_convert(LAS unsigned char* lds, int gw, int NGW, int wave, int lane, const float* w_in, const float* w_out, const float* w_up, const float* w_down, unsigned char* ws) {
    LAS float* scr = (LAS float*)(lds + wave * 16384);
    constexpr int I_IN = 16 * 256, I_OUT = 16 * 32, I_UP = 16 * 128, I_DN = 64 * 32, I_L = I_IN + I_OUT + I_UP + I_DN;
    for (int it = gw; it < 2 * I_L; it += NGW) {
        const int l = it / I_L; int r = it % I_L;
        if (r < I_IN) { const int kb = r / 256, nb = r % 256, n0 = 32 * nb;
            transpose_item(w_in + (size_t)l * DM * INC, INC, n0 < 3072 ? n0 : n0 + 16, 64 * kb, (bf16*)(ws + WS_WIN) + (size_t)l * 8192 * 1024, 1024, n0, scr, lane); continue; }
        r -= I_IN;
        if (r < I_OUT) { const int kb = r / 32, nb = r % 32;
            transpose_item(w_out + (size_t)l * DM * DM, DM, 32 * nb, 64 * kb, (bf16*)(ws + WS_WOUT) + (size_t)l * 1024 * 1024, 1024, 32 * nb, scr, lane); continue; }
        r -= I_OUT;
        if (r < I_UP) { const int kb = r / 128, nb = r % 128;
            transpose_item(w_up + (size_t)l * DM * DFF, DFF, 32 * nb, 64 * kb, (bf16*)(ws + WS_WUP) + (size_t)l * 4096 * 1024, 1024, 32 * nb, scr, lane); continue; }
        r -= I_UP;
        { const int kb = r / 32, nb = r % 32;
            transpose_item(w_down + (size_t)l * DFF * DM, DM, 32 * nb, 64 * kb, (bf16*)(ws + WS_WDN) + (size_t)l * 1024 * 4096, 4096, 32 * nb, scr, lane); }
    }
}

constexpr int NR1 = 1;
DI float selv(bool c, float a, float b) { asm volatile("" : "+v"(a), "+v"(b)); return c ? a : b; }
DI float tsum16(float (&ga)[16], int lane) {
    float a8[8], a4[4], a2[2], a1;
    const bool b5 = lane & 32, b4 = lane & 16, b3 = lane & 8, b2 = lane & 4;
#pragma unroll
    for (int j = 0; j < 8; ++j) { const float snd = selv(b5, ga[j], ga[j + 8]), kp = selv(b5, ga[j + 8], ga[j]); a8[j] = kp + shx(snd, 32, lane); }
#pragma unroll
    for (int j = 0; j < 4; ++j) { const float snd = selv(b4, a8[j], a8[j + 4]), kp = selv(b4, a8[j + 4], a8[j]); a4[j] = kp + shx(snd, 16, lane); }
#pragma unroll
    for (int j = 0; j < 2; ++j) { const float snd = selv(b3, a4[j], a4[j + 2]), kp = selv(b3, a4[j + 2], a4[j]); a2[j] = kp + shx(snd, 8, lane); }
    { const float snd = selv(b2, a2[0], a2[1]), kp = selv(b2, a2[1], a2[0]); a1 = kp + shx(snd, 4, lane); }
    a1 += shx(a1, 2, lane); a1 += shx(a1, 1, lane);
    return a1;
}
typedef float f32x4m __attribute__((ext_vector_type(4)));
DI void phase_rms_gates(LAS unsigned char* lds, int tid, int bx, int G, int wave, int lane, const float* xsrc, const float* g, const float* w_in_l, const float* b_if_l, bf16* XN, float* GATES, float* RSTD1) {
    LAS bf16x8* hiL = (LAS bf16x8*)lds; LAS bf16x8* loL = hiL + 2048;
    __syncthreads();
    for (int idx = tid; idx < 2048; idx += 512) { const int n = idx & 15, k0 = (idx >> 4) * 8; float wv[8], wl_[8];
#pragma unroll
        for (int j = 0; j < 8; ++j) { const float w = w_in_l[(size_t)(k0 + j) * INC + 3072 + n] * g[k0 + j]; const unsigned hb = pk2(w, 0.f) & 0xffffu; wv[j] = __uint_as_float(hb << 16); wl_[j] = w - wv[j]; }
        hiL[idx] = pack8(wv); loL[idx] = pack8(wl_); }
    __syncthreads();
    const int r16 = lane & 15, q = lane >> 4;
    const int kh = wave >> 2;
    LAS float* xch = (LAS float*)(lds + 65536) + (wave & 3) * 320;
    const int grp0 = (G == 256) ? ((((bx >> 3) * 4 + (wave & 3)) >> 6) * 512 + (bx & 7) * 64 + (((bx >> 3) * 4 + (wave & 3)) & 63)) : ((wave & 3) * G + bx);
    for (int grp = grp0; grp < NTOK / 16; grp += 4 * G) {
        const float* xr = xsrc + (size_t)(grp * 16 + r16) * DM + 8 * q;
        f32x4m acc = {0.f, 0.f, 0.f, 0.f}; float ss = 0.f;
#pragma unroll 8
        for (int s_ = kh * 16; s_ < kh * 16 + 16; ++s_) {
            const f32x4 x0 = *(const f32x4*)(xr + 32 * s_), x1 = *(const f32x4*)(xr + 32 * s_ + 4);
            float xv[8] = {x0.x, x0.y, x0.z, x0.w, x1.x, x1.y, x1.z, x1.w}, xh[8], xl[8];
#pragma unroll
            for (int j = 0; j < 8; ++j) { ss += xv[j] * xv[j]; }
#pragma unroll
            for (int j = 0; j < 8; j += 2) { const unsigned hp = pk2(xv[j], xv[j + 1]); xh[j] = __uint_as_float(hp << 16); xh[j + 1] = __uint_as_float(hp & 0xffff0000u); xl[j] = xv[j] - xh[j]; xl[j + 1] = xv[j + 1] - xh[j + 1]; }
            { const f32x4 g0 = *(const f32x4*)(g + 32 * s_ + 8 * q), g1 = *(const f32x4*)(g + 32 * s_ + 8 * q + 4);
              const f32x4 o0 = x0 * g0, o1 = x1 * g1; u32x4 w4 = {pk2(o0.x, o0.y), pk2(o0.z, o0.w), pk2(o1.x, o1.y), pk2(o1.z, o1.w)};
              *(u32x4*)(XN + (size_t)(grp * 16 + r16) * DM + 8 * q + 32 * s_) = w4; }
            const bf16x8 ah = pack8(xh), al = pack8(xl);
            const bf16x8 wh = hiL[(s_ * 4 + q) * 16 + r16], wlo = loL[(s_ * 4 + q) * 16 + r16];
            acc = __builtin_amdgcn_mfma_f32_16x16x32_bf16(ah, wh, acc, 0, 0, 0);
            acc = __builtin_amdgcn_mfma_f32_16x16x32_bf16(al, wh, acc, 0, 0, 0);
            acc = __builtin_amdgcn_mfma_f32_16x16x32_bf16(ah, wlo, acc, 0, 0, 0);
        }
        __syncthreads();
        if (kh == 1) { xch[lane] = acc[0]; xch[64 + lane] = acc[1]; xch[128 + lane] = acc[2]; xch[192 + lane] = acc[3]; xch[256 + lane] = ss; }
        __syncthreads();
        if (kh == 0) { acc[0] += xch[lane]; acc[1] += xch[64 + lane]; acc[2] += xch[128 + lane]; acc[3] += xch[192 + lane]; ss += xch[256 + lane]; }
        ss += shx(ss, 16, lane); ss += shx(ss, 32, lane);
        const float rstd = 1.0f / sqrtf(ss * (1.0f / DM) + EPS);
        const float bias = b_if_l[r16];
#pragma unroll
        for (int i = 0; i < 4; ++i) { const float rs = shi(rstd, 4 * q + i); if (kh == 0) GATES[(size_t)r16 * NTOK + grp * 16 + 4 * q + i] = rs * acc[i] + bias; }
        if (kh == 0 && q == 0) RSTD1[grp * 16 + r16] = rstd;
    }
    __syncthreads();
}
DI void phase_rms(int gw, int NGW, int lane, const float* xsrc, const float* g, bf16* XN) {
    f32x4 gg[4];
#pragma unroll
    for (int j = 0; j < 4; ++j) gg[j] = *(const f32x4*)(g + 4 * lane + 256 * j);
    for (int row0 = gw; row0 < NTOK; row0 += 4 * NGW) {
        f32x4 v[4][4];
#pragma unroll
        for (int r = 0; r < 4; ++r) { const int row = row0 + r * NGW; const float* xr = xsrc + (size_t)(row < NTOK ? row : row0) * DM;
#pragma unroll
            for (int j = 0; j < 4; ++j) v[r][j] = *(const f32x4*)(xr + 4 * lane + 256 * j); }
#pragma unroll
        for (int r = 0; r < 4; ++r) { const int row = row0 + r * NGW; float ss = 0.f;
#pragma unroll
            for (int j = 0; j < 4; ++j) ss += (v[r][j].x * v[r][j].x + v[r][j].y * v[r][j].y) + (v[r][j].z * v[r][j].z + v[r][j].w * v[r][j].w);
            ss = wave_sum(ss, lane);
            const float rstd = 1.0f / sqrtf(ss * (1.0f / DM) + EPS);
            if (row < NTOK) {
#pragma unroll
                for (int j = 0; j < 4; ++j) { const f32x4 o = v[r][j] * rstd * gg[j];
                    u32x2 w2 = {pk2(o.x, o.y), pk2(o.z, o.w)}; *(u32x2*)(XN + (size_t)row * DM + 4 * lane + 256 * j) = w2; } }
        }
    }
}

#define CONV_ROWS_LOOP(MASKED, ROWEXPR_STORE) \
    _Pragma("unroll") for (int it = 0; it < NIT; ++it) if (it < nit) { const int row = it * 8 + r8; const int pos = pos0 + row; float o[8]; \
        _Pragma("unroll") for (int j = 0; j < 8; ++j) o[j] = 0.f; \
        _Pragma("unroll") for (int jj = 0; jj < 4; ++jj) { const int p = pos - 3 + jj; const float msk = (MASKED && p < 0) ? 0.f : 1.f;   \
            { const bf16x8 raw = *(const bf16x8*)(col + (size_t)(tb + ((MASKED && p < 0) ? 0 : p)) * PW + oct * 8); const f32x4 wam = MASKED ? wa[jj] * msk : wa[jj], wbm = MASKED ? wb[jj] * msk : wb[jj]; \
                o[0] += wam.x * bf2f(raw[0]); o[1] += wam.y * bf2f(raw[1]); o[2] += wam.z * bf2f(raw[2]); o[3] += wam.w * bf2f(raw[3]); \
                o[4] += wbm.x * bf2f(raw[4]); o[5] += wbm.y * bf2f(raw[5]); o[6] += wbm.z * bf2f(raw[6]); o[7] += wbm.w * bf2f(raw[7]); } } \
        ROWEXPR_STORE }
#define CONV_ROWS_BODY(ROWEXPR_STORE) \
    const int oct = lane & 7, r8 = lane >> 3; \
    f32x4 wa[4], wb[4]; \
    _Pragma("unroll") for (int jj = 0; jj < 4; ++jj) { wa[jj] = *(const f32x4*)(cwp + jj * 1024 + oct * 8); wb[jj] = *(const f32x4*)(cwp + jj * 1024 + oct * 8 + 4); } \
    if (pos0 >= 3) { CONV_ROWS_LOOP(false, ROWEXPR_STORE) } else { CONV_ROWS_LOOP(true, ROWEXPR_STORE) }
template <int NIT> DI void stage_conv_rows(LAS bf16* dst, const bf16* col, const float* cwp, int tb, int pos0, int nit, float scale, int lane) {
    CONV_ROWS_BODY({ _Pragma("unroll") for (int j = 0; j < 8; ++j) o[j] = o[j] * sigm(o[j]) * scale; *(LAS bf16x8*)(dst + row * 72 + oct * 8) = pack8(o); })
}
template <int NIT> DI void stage_conv_rows_t(LAS bf16* dst, const bf16* col, const float* cwp, int tb, int pos0, int nit, float scale, const LAS float* wrow, int lane) {
    CONV_ROWS_BODY({ const float wsc = wrow[row] * scale; _Pragma("unroll") for (int j = 0; j < 8; j += 2) { const unsigned pk = pk2(o[j] * sigm(o[j]) * wsc, o[j + 1] * sigm(o[j + 1]) * wsc);
        dst[(oct * 8 + j) * 72 + row] = (bf16)(pk & 0xffffu); dst[(oct * 8 + j + 1) * 72 + row] = (bf16)(pk >> 16); } })
}

DI void mlstm_a_unit(int u, int hf, int lane, LAS float* scr, const bf16* P, const bf16* VtA, bf16* SL, const float* GATES, float* MLOC, float* BLAST, float* NLOC, const float* cw, float* rk2) {
    asm volatile("" : "+v"(lane));
    LAS bf16* img = (LAS bf16*)(scr + 256);
    const int dvh = u & 1, c = (u >> 1) & 63, bhl = u >> 7;
    const int bl = bhl >> 3, h = bhl & 7, bhg = hf * 16 + bhl;
    const int tb = bl * SEQ, l31 = lane & 31, hi = lane >> 5;
    bf16x8 vf[2][4];
#pragma unroll
    for (int dvb = 0; dvb < 2; ++dvb) {
#pragma unroll
        for (int st = 0; st < 4; ++st) vf[dvb][st] = *(const bf16x8*)(VtA + ((size_t)bhl * 128 + c * 2 + (st >> 1)) * 4096 + ((dvh * 2 + dvb) * 2 + (st & 1)) * 512 + l31 * 16 + hi * 8);
    }
    if (dvh == 0) { float* rp = rk2 + (size_t)bhl * 4096 + c * 64 + lane; *rp = __builtin_amdgcn_rsqf(*rp * (1.0f / 128.f) + EPS); }
    const int gt = hf * HTOK + tb + c * 64 + lane;
    const float fpre = GATES[(size_t)(8 + h) * NTOK + gt], ipre = GATES[(size_t)h * NTOK + gt];
    const float lf = logsigmoid_(fpre);
    const float b = scan_add(lf, lane);
    const float blast = shi(b, 63);
    const float av = blast - b + ipre;
    const float mloc = wave_max(av, lane);
    const float w = expf(av - mloc);
    LDS_FENCE(); scr[lane] = w; LDS_FENCE();
    stage_conv_rows_t<8>(img, P + PC_KA + h * 64, cw + 512 + h * 64, tb, c * 64, 8, 0.125f, scr, lane);
    LDS_FENCE();
#pragma unroll
    for (int dkb = 0; dkb < 2; ++dkb) {
        bf16x8 kwf[4]; float nl = 0.f;
#pragma unroll
        for (int st = 0; st < 4; ++st) { { const s16x4 lo = *(const LAS s16x4*)(img + (dkb * 32 + l31) * 72 + st * 16 + 4 * hi), hh = *(const LAS s16x4*)(img + (dkb * 32 + l31) * 72 + st * 16 + 8 + 4 * hi);
                kwf[st] = (bf16x8){lo[0], lo[1], lo[2], lo[3], hh[0], hh[1], hh[2], hh[3]}; }
#pragma unroll
            for (int j = 0; j < 8; ++j) nl += bf2f(kwf[st][j]); }
        f32x16 acc[2];
#pragma unroll
        for (int a = 0; a < 2; ++a)
#pragma unroll
            for (int r = 0; r < 16; ++r) acc[a][r] = 0.f;
#pragma unroll
        for (int dvb = 0; dvb < 2; ++dvb)
#pragma unroll
            for (int st = 0; st < 4; ++st) acc[dvb] = MFMA32(kwf[st], vf[dvb][st], acc[dvb]);
#pragma unroll
        for (int dvb = 0; dvb < 2; ++dvb) {
            bf16* dst = SL + (size_t)(bhl * 64 + c) * 8192 + (size_t)((dvh * 2 + dvb) * 4 + dkb * 2) * 512 + l31 * 16 + 4 * hi;
#pragma unroll
            for (int g = 0; g < 4; ++g) { u32x2 w2 = {pk2(acc[dvb][4 * g], acc[dvb][4 * g + 1]), pk2(acc[dvb][4 * g + 2], acc[dvb][4 * g + 3])}; *(u32x2*)(dst + (g >> 1) * 512 + (g & 1) * 8) = w2; } }
        if (dvh == 0) { const float n = nl + shx(nl, 32, lane); if (hi == 0) NLOC[(size_t)(bhg * 64 + c) * 64 + dkb * 32 + l31] = n; }
    }
    if (dvh == 0 && lane == 0) { MLOC[bhg * 64 + c] = mloc; BLAST[bhg * 64 + c] = blast; }
    LDS_FENCE();
}

DI void phase_scan(LAS unsigned char* lds, int bx, int G, int tid, int hf, bf16* SL, const float* MLOC, const float* BLAST, float* M0, float* NLOC) {
    LAS float* spL = (LAS float*)lds; LAS float* slL = spL + 64;
    for (int blk = bx; blk < 128; blk += G) {
        const int bhl = blk >> 3, pair = (blk & 7) * 512 + tid, bhg = hf * 16 + bhl;
        __syncthreads();
        if (tid < 64) { const float ml = MLOC[bhg * 64 + tid], bl = BLAST[bhg * 64 + tid];
            const float B = scan_add(bl, tid); const float t = scan_max(ml - B, tid); const float m = B + fmaxf(0.f, t);
            float mprev = shi(m, tid > 0 ? tid - 1 : 0); if (tid == 0) mprev = 0.f;
            spL[tid] = expf(bl + mprev - m); slL[tid] = expf(ml - m);
            if ((blk & 7) == 0) M0[bhg * 64 + tid] = mprev; }
        __syncthreads();
        unsigned* base = (unsigned*)(SL + (size_t)bhl * 64 * 8192) + pair;
        unsigned v[64];
#pragma unroll
        for (int c = 0; c < 64; ++c) v[c] = base[(size_t)c * 4096];
        float s0 = 0.f, s1 = 0.f;
#pragma unroll
        for (int c = 0; c < 64; ++c) {
            const float sp = spL[c], sl = slL[c];
            base[(size_t)c * 4096] = pk2(s0, s1);
            s0 = sp * s0 + sl * __uint_as_float(v[c] << 16); s1 = sp * s1 + sl * __uint_as_float(v[c] & 0xffff0000u);
        }
        if ((blk & 7) == 0 && tid < 64) {
            float* nb = NLOC + (size_t)bhg * 64 * 64 + tid;
            float nv[64];
#pragma unroll
            for (int c = 0; c < 64; ++c) nv[c] = nb[c * 64];
            float n0 = 0.f;
#pragma unroll
            for (int c = 0; c < 64; ++c) { nb[c * 64] = n0; n0 = spL[c] * n0 + slL[c] * nv[c]; }
        }
    }
    __syncthreads();
}

DI void mlstm_c_unit(int u, int hf, int lane, LAS float* scr, const bf16* P, const bf16* VtA, const bf16* SL, const float* GATES, const float* M0, const float* N0,
                     const float* cw, const float* ng, const float* bgate, bf16* Y) {
    asm volatile("" : "+v"(lane));
    LAS bf16* qS = (LAS bf16*)(scr + 256);
    const int th = u & 1, c = (u >> 1) & 63, bhl = u >> 7;
    LAS bf16* kS = (LAS bf16*)(scr - th * 4608 + 256) + 32 * 72;
    const int bl = bhl >> 3, h = bhl & 7, bhg = hf * 16 + bhl;
    const int tb = bl * SEQ, l31 = lane & 31, hi = lane >> 5;
    const int gt = hf * HTOK + tb + c * 64 + lane;
    const float fpre = GATES[(size_t)(8 + h) * NTOK + gt], ipre = GATES[(size_t)h * NTOK + gt];
    f32x4 n0v[4][2];
#pragma unroll
    for (int st = 0; st < 4; ++st) { n0v[st][0] = *(const f32x4*)(N0 + (size_t)(bhg * 64 + c) * 64 + st * 16 + hi * 8); n0v[st][1] = *(const f32x4*)(N0 + (size_t)(bhg * 64 + c) * 64 + st * 16 + hi * 8 + 4); }
    bf16x8 sfr[4][4];
#pragma unroll
    for (int dvb = 0; dvb < 4; ++dvb)
#pragma unroll
        for (int st = 0; st < 4; ++st) sfr[dvb][st] = *(const bf16x8*)(SL + (size_t)(bhl * 64 + c) * 8192 + (size_t)(dvb * 4 + st) * 512 + l31 * 16 + hi * 8);
    const float lf = logsigmoid_(fpre);
    const float b = scan_add(lf, lane);
    const float us = ipre - b;
    const float cm = scan_max(us, lane);
    const float m0 = M0[bhg * 64 + c];
    const float mt = b + fmaxf(m0, cm);
    LDS_FENCE();
    scr[lane] = us; scr[64 + lane] = b - mt; scr[128 + lane] = expf(b + m0 - mt); scr[192 + lane] = expf(-mt);
    stage_conv_rows<4>(qS, P + PC_QA + h * 64, cw + h * 64, tb, c * 64 + th * 32, 4, 1.0f, lane);
    stage_conv_rows<4>(kS + th * 32 * 72, P + PC_KA + h * 64, cw + 512 + h * 64, tb, c * 64 + th * 32, 4, 0.125f, lane);
    LDS_FENCE();
    __syncthreads();
    const int tl = th * 32 + l31;
    const float ct_t = scr[64 + tl], inter_t = scr[128 + tl], emn_t = scr[192 + tl];
    bf16x8 qf[4]; float qn0 = 0.f;
#pragma unroll
    for (int st = 0; st < 4; ++st) { const int dk0 = st * 16 + hi * 8;
        qf[st] = *(const LAS bf16x8*)(qS + l31 * 72 + dk0);
        const f32x4 na = n0v[st][0], nb = n0v[st][1];
        qn0 += bf2f(qf[st][0]) * na.x + bf2f(qf[st][1]) * na.y + bf2f(qf[st][2]) * na.z + bf2f(qf[st][3]) * na.w
             + bf2f(qf[st][4]) * nb.x + bf2f(qf[st][5]) * nb.y + bf2f(qf[st][6]) * nb.z + bf2f(qf[st][7]) * nb.w; }
    f32x16 acc[4];
#pragma unroll
    for (int a = 0; a < 4; ++a)
#pragma unroll
        for (int r = 0; r < 16; ++r) acc[a][r] = 0.f;
#pragma unroll
    for (int dvb = 0; dvb < 4; ++dvb)
#pragma unroll
        for (int st = 0; st < 4; ++st) acc[dvb] = MFMA32(sfr[dvb][st], qf[st], acc[dvb]);
#pragma unroll
    for (int dvb = 0; dvb < 4; ++dvb)
#pragma unroll
        for (int r = 0; r < 16; ++r) acc[dvb][r] *= inter_t;
    asm volatile("" ::: "memory");
    float den = 0.f;
    for (int kb = 0; kb <= th; ++kb) {
        bf16x8 vfr[4][2];
        { const bf16* vb_ = VtA + ((size_t)bhl * 128 + c * 2 + kb) * 4096 + l31 * 16 + hi * 8;
#pragma unroll
          for (int dvb = 0; dvb < 4; ++dvb)
#pragma unroll
            for (int s2 = 0; s2 < 2; ++s2) vfr[dvb][s2] = *(const bf16x8*)(vb_ + (dvb * 2 + s2) * 512); }
        f32x16 s;
#pragma unroll
        for (int r = 0; r < 16; ++r) s[r] = 0.f;
#pragma unroll
        for (int st = 0; st < 4; ++st) { const bf16x8 kf = *(const LAS bf16x8*)(kS + (kb * 32 + l31) * 72 + st * 16 + hi * 8); s = MFMA32(kf, qf[st], s); }
        float pv[16];
#pragma unroll
        for (int g = 0; g < 4; ++g) { const f32x4 u4 = *(const LAS f32x4*)(scr + kb * 32 + 8 * g + 4 * hi);
#pragma unroll
            for (int i = 0; i < 4; ++i) { const int r = 4 * g + i; const int sidx = kb * 32 + 8 * g + 4 * hi + i;
                const float p = (sidx <= tl) ? __expf(ct_t + u4[i]) * s[r] : 0.f; den += p; pv[r] = p; } }
        bf16x8 pf[2]; pf[0] = pack8(pv); pf[1] = pack8(pv + 8);
#pragma unroll
        for (int dvb = 0; dvb < 4; ++dvb)
#pragma unroll
            for (int s2 = 0; s2 < 2; ++s2) acc[dvb] = MFMA32(vfr[dvb][s2], pf[s2], acc[dvb]);
    }
    den += shx(den, 32, lane); qn0 += shx(qn0, 32, lane);
    den += inter_t * qn0;
    const float inv = 1.0f / fmaxf(fabsf(den), emn_t);
    float ss = 0.f;
#pragma unroll
    for (int dvb = 0; dvb < 4; ++dvb)
#pragma unroll
        for (int r = 0; r < 16; ++r) { const float hv = acc[dvb][r] * inv; acc[dvb][r] = hv; ss += hv * hv; }
    ss += shx(ss, 32, lane);
    const float rn = 1.0f / sqrtf(ss * (1.0f / 128.f) + EPS);
    LAS bf16* hL = (LAS bf16*)(scr + 256);
    LDS_FENCE();
    __syncthreads();
#pragma unroll
    for (int dvb = 0; dvb < 4; ++dvb)
#pragma unroll
        for (int g = 0; g < 4; ++g) { u32x2 w2 = {pk2(acc[dvb][4 * g] * rn, acc[dvb][4 * g + 1] * rn), pk2(acc[dvb][4 * g + 2] * rn, acc[dvb][4 * g + 3] * rn)};
            *(LAS u32x2*)(hL + l31 * 136 + dvb * 32 + 8 * g + 4 * hi) = w2; }
    LDS_FENCE();
    const int c16 = lane & 15, r4 = lane >> 4;
    const int ch0 = h * 128 + c16 * 8;
    const f32x4 ng0 = *(const f32x4*)(ng + ch0), ng1 = *(const f32x4*)(ng + ch0 + 4), ba0 = *(const f32x4*)(bgate + ch0), ba1 = *(const f32x4*)(bgate + ch0 + 4),
                bb0 = *(const f32x4*)(bgate + 1024 + ch0), bb1 = *(const f32x4*)(bgate + 1024 + ch0 + 4);
#pragma unroll
    for (int half_ = 0; half_ < 2; ++half_) {
        bf16x8 oa[4], ga[4], gb[4], yb[4];
#pragma unroll
        for (int it = 0; it < 4; ++it) { const int rl = (half_ * 4 + it) * 4 + r4; const bf16* prow = P + (size_t)(tb + c * 64 + th * 32 + rl) * PW + ch0;
            oa[it] = *(const bf16x8*)(prow + PC_OA); ga[it] = *(const bf16x8*)(prow + PC_GA); gb[it] = *(const bf16x8*)(prow + PC_GB); yb[it] = *(const bf16x8*)(prow + PC_QB); }
#pragma unroll
        for (int it = 0; it < 4; ++it) { const int rl = (half_ * 4 + it) * 4 + r4;
            const bf16x8 hv = *(const LAS bf16x8*)(hL + rl * 136 + c16 * 8);
            float o[8];
#pragma unroll
            for (int j = 0; j < 8; ++j) { const float ngj = j < 4 ? ng0[j & 3] : ng1[j & 3], baj = j < 4 ? ba0[j & 3] : ba1[j & 3], bbj = j < 4 ? bb0[j & 3] : bb1[j & 3];
                const float ya = sigm(bf2f(oa[it][j])) * (bf2f(hv[j]) * ngj);
                o[j] = sigm(bf2f(ga[it][j]) + baj) * ya + sigm(bf2f(gb[it][j]) + bbj) * bf2f(yb[it][j]); }
            *(bf16x8*)(Y + (size_t)(hf * HTOK + tb + c * 64 + th * 32 + rl) * DM + ch0) = pack8(o); }
        asm volatile("" ::: "memory");
    }
    LDS_FENCE();
    __syncthreads();
}

DI void sb_unit(int u, int lane, LAS float* scr, bf16* P, const bf16* Kf, const float* rk2, const bf16* VtB, const float* gq, const float* gk, bf16* dummy) {
    asm volatile("" : "+v"(lane));
    const int bhl = u >> 7, qt = u & 127, bl = bhl >> 3, h = bhl & 7;
    const int tb = bl * SEQ, q0 = qt * 32, l31 = lane & 31, hi = lane >> 5;
    LAS bf16x8* qL = (LAS bf16x8*)(scr + 256);
    {
        const int c16 = lane & 15, r4 = lane >> 4;
        LAS float* coefW = scr + 2304;
        LDS_FENCE();
        coefW[lane] = gq[lane] * gk[lane]; coefW[64 + lane] = gq[64 + lane] * gk[64 + lane];
        bf16x8 qraw[8];
#pragma unroll
        for (int it = 0; it < 8; ++it) qraw[it] = *(const bf16x8*)(P + (size_t)(tb + q0 + it * 4 + r4) * PW + PC_QB + h * 128 + c16 * 8);
        LDS_FENCE();
        const f32x4 c0 = *(const LAS f32x4*)(coefW + c16 * 8), c1 = *(const LAS f32x4*)(coefW + c16 * 8 + 4);
#pragma unroll
        for (int it = 0; it < 8; ++it) { float ss = 0.f;
#pragma unroll
            for (int j = 0; j < 8; ++j) { const float v = bf2f(qraw[it][j]); ss += v * v; }
            ss += shx(ss, 1, lane); ss += shx(ss, 2, lane); ss += shx(ss, 4, lane); ss += shx(ss, 8, lane);
            const float rq = (1.0f / sqrtf(ss * (1.0f / 128.f) + EPS)) * (0.08838834764831845f * 1.4426950408889634f);
            float qv[8];
#pragma unroll
            for (int j = 0; j < 8; ++j) qv[j] = bf2f(qraw[it][j]) * rq * (j < 4 ? c0[j & 3] : c1[j & 3]);
            qL[(c16 >> 1) * 64 + (c16 & 1) * 32 + it * 4 + r4] = pack8(qv); }
    }
    LDS_FENCE();
    f32x16 o[4];
#pragma unroll
    for (int a = 0; a < 4; ++a)
#pragma unroll
        for (int r = 0; r < 16; ++r) o[a][r] = 0.f;
    float C = 1.0f;
    const int tq = q0 + l31;
    const bf16* kbase = Kf + (size_t)bhl * 128 * 4096 + l31 * 16 + hi * 8;
    u32x4 kfu[8];
    f32x4 rkq[4];
    const float* rkbase = rk2 + (size_t)bhl * 4096 + 4 * hi;
#define KLOAD(kt_) do { const bf16* kp_ = kbase + (size_t)(kt_) * 4096; _Pragma("unroll") for (int st = 0; st < 8; ++st) asm volatile("global_load_dwordx4 %0, %1, off" : "=v"(kfu[st]) : "v"(kp_ + st * 512)); \
        const float* rp_ = rkbase + (kt_) * 32; _Pragma("unroll") for (int g = 0; g < 4; ++g) asm volatile("global_load_dwordx4 %0, %1, off" : "=v"(rkq[g]) : "v"(rp_ + 8 * g)); } while (0)
#define KWAIT() asm volatile("s_waitcnt vmcnt(0)" : "+v"(kfu[0]), "+v"(kfu[1]), "+v"(kfu[2]), "+v"(kfu[3]), "+v"(kfu[4]), "+v"(kfu[5]), "+v"(kfu[6]), "+v"(kfu[7]), "+v"(rkq[0]), "+v"(rkq[1]), "+v"(rkq[2]), "+v"(rkq[3]) :: "memory")
    KLOAD(qt);
    for (int kt = qt; kt >= 0; --kt) {
        KWAIT();
        bf16x8 kf[8];
#pragma unroll
        for (int st = 0; st < 8; ++st) kf[st] = __builtin_bit_cast(bf16x8, kfu[st]);
        f32x4 rk4[4];
#pragma unroll
        for (int g = 0; g < 4; ++g) { const f32x4 q2 = rkq[g];
#pragma unroll
            for (int i = 0; i < 4; ++i) rk4[g][i] = q2[i]; }
        bf16x8 vfr[4][2];
        { const bf16* vb_ = VtB + ((size_t)bhl * 128 + kt) * 4096 + l31 * 16 + hi * 8;
#pragma unroll
          for (int db = 0; db < 4; ++db)
#pragma unroll
            for (int s2 = 0; s2 < 2; ++s2) vfr[db][s2] = *(const bf16x8*)(vb_ + (db * 2 + s2) * 512); }
        f32x16 s, sB;
#pragma unroll
        for (int r = 0; r < 16; ++r) { s[r] = 0.f; sB[r] = 0.f; }
#pragma unroll
        for (int st = 0; st < 8; st += 2) { s = MFMA32(kf[st], qL[st * 64 + lane], s); sB = MFMA32(kf[st + 1], qL[(st + 1) * 64 + lane], sB); }
#pragma unroll
        for (int r = 0; r < 16; ++r) s[r] += sB[r];
        asm volatile("" ::: "memory");
        KLOAD(kt > 0 ? kt - 1 : 0);
        float btl[16], tot[4], ot[4];
#pragma unroll
        for (int g = 0; g < 4; ++g) { float kp[4], bt[4];
#pragma unroll
            for (int i = 0; i < 4; ++i) { const int r = 4 * g + i; const float e = __builtin_amdgcn_exp2f(s[r] * rk4[g][i]); float k_ = __builtin_amdgcn_rcpf(1.f + e); float b_ = 1.f - k_;
                if (kt == qt) { const int key = kt * 32 + crow(r, hi); if (key >= tq) { k_ = 1.f; b_ = 0.f; } }
                kp[i] = k_; bt[i] = b_; }
            const float s2_ = kp[3], s1_ = s2_ * kp[2], s0_ = s1_ * kp[1];
            btl[4 * g + 3] = bt[3]; btl[4 * g + 2] = bt[2] * s2_; btl[4 * g + 1] = bt[1] * s1_; btl[4 * g] = bt[0] * s0_; tot[g] = s0_ * kp[0]; }
#pragma unroll
        for (int g = 0; g < 4; ++g) ot[g] = shx(tot[g], 32, lane);
        float T[8], suf[8];
#pragma unroll
        for (int g = 0; g < 4; ++g) { T[2 * g] = hi ? ot[g] : tot[g]; T[2 * g + 1] = hi ? tot[g] : ot[g]; }
        suf[7] = 1.f;
#pragma unroll
        for (int G = 6; G >= 0; --G) suf[G] = suf[G + 1] * T[G + 1];
        const float total = suf[0] * T[0];
#pragma unroll
        for (int g = 0; g < 4; ++g) { const float Eg = (hi ? suf[2 * g + 1] : suf[2 * g]) * C;
#pragma unroll
            for (int i = 0; i < 4; ++i) btl[4 * g + i] *= Eg; }
        C *= total;
        bf16x8 pf[2]; pf[0] = pack8(btl); pf[1] = pack8(btl + 8);
#pragma unroll
        for (int db = 0; db < 4; ++db)
#pragma unroll
            for (int s2 = 0; s2 < 2; ++s2) o[db] = MFMA32(vfr[db][s2], pf[s2], o[db]);
        if (__all(C == 0.f)) break;
    }
    KWAIT();
#undef KLOAD
#undef KWAIT
    LAS bf16* oL = (LAS bf16*)(scr + 256);
    LDS_FENCE();
#pragma unroll
    for (int db = 0; db < 4; ++db)
#pragma unroll
        for (int g = 0; g < 4; ++g) { u32x2 w2 = {pk2(o[db][4 * g], o[db][4 * g + 1]), pk2(o[db][4 * g + 2], o[db][4 * g + 3])}; *(LAS u32x2*)(oL + l31 * 136 + db * 32 + 8 * g + 4 * hi) = w2; }
    LDS_FENCE();
    { const int c16 = lane & 15, r4 = lane >> 4;
#pragma unroll
      for (int it = 0; it < 8; ++it) { const int rl = it * 4 + r4; const bf16x8 v = *(const LAS bf16x8*)(oL + rl * 136 + c16 * 8);
          bf16* dst = dummy ? dummy + (size_t)((tb + q0 + rl) & 4095) * 1024 + h * 128 + c16 * 8 : P + (size_t)(tb + q0 + rl) * PW + PC_QB + h * 128 + c16 * 8;
          *(bf16x8*)dst = v; } }
    LDS_FENCE();
}

#define XB_TMO      128
#define XB_XCNT(j)  (256  + 64 * (j))
#define XB_XSUB(j)  (1280 + 64 * (j))
#define XB_XGEN(j)  (2304 + 64 * (j))
#define XB_TOP      3328
#define XB_TOPGEN   3392
#define XCD_BAR_WORDS 3456
#define XB_SPIN_CAP (1u << 18)

__device__ __forceinline__ unsigned xb_ld(unsigned* p)              { return __hip_atomic_load(p, __ATOMIC_RELAXED, __HIP_MEMORY_SCOPE_AGENT); }
__device__ __forceinline__ unsigned xb_add(unsigned* p, unsigned v) { return __hip_atomic_fetch_add(p, v, __ATOMIC_RELAXED, __HIP_MEMORY_SCOPE_AGENT); }
__device__ __forceinline__ unsigned xb_xcc_id() { return (unsigned)__builtin_amdgcn_s_getreg((3 << 11) | 20) & 0xFu; }
#define XB_SPIN(cond, bar) do { unsigned _sp = 0; while (cond) { __builtin_amdgcn_s_sleep(1); \
    if ((++_sp & 255u) == 0u) { if (xb_ld(&(bar)[XB_TMO])) break; if (_sp > XB_SPIN_CAP) { atomicAdd(&(bar)[XB_TMO], 1u); break; } } } } while (0)

struct XcdBarrier {
    unsigned* bar; unsigned x;
    volatile LAS unsigned* st;
};

__device__ __forceinline__ XcdBarrier xcd_barrier_post(unsigned* bar, volatile LAS unsigned* st) {
    XcdBarrier b; b.bar = bar; b.x = xb_xcc_id(); b.st = st;
    if (threadIdx.x == 0) (void)xb_add(&bar[XB_XCNT(b.x)], 1u);
    return b;
}
__device__ __forceinline__ void xcd_barrier_complete(unsigned* bar, unsigned x, unsigned& nloc, unsigned& nx) {
    const unsigned G = gridDim.x * gridDim.y * gridDim.z;
    unsigned sum, cnt, mine, sp = 0u;
    for (;;) {
        sum = 0u; cnt = 0u; mine = 0u;
#pragma unroll
        for (unsigned j = 0; j < 16; ++j) { const unsigned c = xb_ld(&bar[XB_XCNT(j)]); sum += c; cnt += (c > 0u) ? 1u : 0u; mine = (j == x) ? c : mine; }
        if (sum == G) break;
        __builtin_amdgcn_s_sleep(1);
        if ((++sp & 255u) == 0u) { if (xb_ld(&bar[XB_TMO])) break; if (sp > XB_SPIN_CAP) { atomicAdd(&bar[XB_TMO], 1u); break; } }
    }
    nloc = mine > 0u ? mine : 1u; nx = cnt > 0u ? cnt : 1u;
}

__device__ __forceinline__ void xcd_barrier(const XcdBarrier& b) {
    asm volatile("s_waitcnt vmcnt(0)" ::: "memory");
    __syncthreads();
    if (threadIdx.x == 0) {
        unsigned* bar = b.bar;
        __builtin_amdgcn_s_waitcnt(0);
        unsigned nloc = b.st[0], nx = b.st[1];
        if (nloc == 0u) { xcd_barrier_complete(bar, b.x, nloc, nx); b.st[0] = nloc; b.st[1] = nx; }
        const unsigned old = xb_add(&bar[XB_XSUB(b.x)], 1u);
        const unsigned gen = old / nloc;
        if (old + 1u == (gen + 1u) * nloc) {
            __builtin_amdgcn_fence(__ATOMIC_RELEASE, "agent");
            asm volatile("s_waitcnt vmcnt(0)" ::: "memory");
            const unsigned og = xb_add(&bar[XB_TOP], 1u);
            const unsigned tg = og / nx;
            if (og + 1u == (tg + 1u) * nx) xb_add(&bar[XB_TOPGEN], 1u);
            else XB_SPIN(xb_ld(&bar[XB_TOPGEN]) == tg, bar);
            __builtin_amdgcn_fence(__ATOMIC_ACQUIRE, "agent");
            xb_add(&bar[XB_XGEN(b.x)], 1u);
            asm volatile("s_waitcnt vmcnt(0)" ::: "memory");
        } else {
            XB_SPIN(xb_ld(&bar[XB_XGEN(b.x)]) == gen, bar);
            __builtin_amdgcn_fence(__ATOMIC_ACQUIRE, "agent");
            asm volatile("s_waitcnt vmcnt(0)" ::: "memory");
        }
    }
    __syncthreads();
}

#ifndef PROBE_ID
#define PROBE_ID 0
#endif
#define REP_SMALL ((PROBE_ID == 1) ? 2 : 1)
#define REP_RMS ((PROBE_ID == 1 || PROBE_ID == 9) ? 2 : 1)
#define REP_MA ((PROBE_ID == 1 || PROBE_ID == 10) ? 2 : 1)
#define REP_MC ((PROBE_ID == 1 || PROBE_ID == 11) ? 2 : 1)
#define REP_GEMM ((PROBE_ID == 2) ? 2 : 1)
#define REP_SB ((PROBE_ID == 3) ? 2 : 1)
#define REP_SYNC ((PROBE_ID == 4) ? 2 : 1)
struct Args { const float* in[13]; float* out; unsigned char* ws; int ph_lo, ph_hi; };
typedef const volatile __attribute__((address_space(4))) unsigned long long* kargv_t;
DI const float* argp(int i) { kargv_t ka = (kargv_t)__builtin_amdgcn_kernarg_segment_ptr(); return (const float*)(const __attribute__((address_space(1))) float*)ka[i]; }
#define A_IN(i) argp(i)
#define A_OUT ((float*)argp(13))
#define A_WS ((unsigned char*)argp(14))
__global__ void __launch_bounds__(512, 2) fwd_kernel(Args a) {
    extern __shared__ __attribute__((aligned(16))) unsigned char lds_raw[];
    cg::grid_group grid = cg::this_grid();
    LAS unsigned char* lds = (LAS unsigned char*)lds_raw;
    const int G = gridDim.x, NGW = G * 8;
#define PH_BEGIN() int tid = threadIdx.x; asm volatile("" : "+v"(tid)); int bx = blockIdx.x; asm volatile("" : "+s"(bx)); \
    const int lane = tid & 63, wave = __builtin_amdgcn_readfirstlane(tid >> 6), gw = bx * 8 + wave; LAS float* scr = (LAS float*)(lds + wave * 18432); (void)scr; (void)gw; (void)lane
#define XN ((bf16*)(A_WS + WS_XN))
#define Pb ((bf16*)(A_WS + WS_P))
#define VtA ((bf16*)(A_WS + WS_VTA))
#define VtB ((bf16*)(A_WS + WS_VTB))
#define SL ((bf16*)(A_WS + WS_SL))
#define GATES ((float*)(A_WS + WS_GATES))
#define MLOC ((float*)(A_WS + WS_STATS))
#define BLAST (MLOC + 2048)
#define M0 (MLOC + 4096)
#define NLOC (MLOC + 16384)
#define RSQ (MLOC + 200000)
#define RSTD1P (MLOC + 220000)
#define RK2P (MLOC + 240000)
#define xout A_OUT
#define x_in A_IN(0)
#define ws A_WS
    const int lo = a.ph_lo, hi = a.ph_hi;
    int step = 0;
    if (lo < 0) grid.sync();
    if (hi - lo > 1) {
        if (threadIdx.x < 16) ((volatile LAS unsigned*)(lds + 147456))[threadIdx.x] = 0u;
        __syncthreads();
        (void)xcd_barrier_post((unsigned*)A_WS, (volatile LAS unsigned*)(lds + 147456) + 8);
    }
#define GWV() ((G == 256) ? ((((((bx >> 2) & 1) << 7) | (((bx >> 5) & 7) << 4) | ((bx & 3) << 2) | ((bx >> 3) & 3)) << 3) + wave) : gw)
#define RUN() (step >= lo && step < hi)
#define SEAM() do { if (step >= lo && step + 1 < hi) { for (int rs_ = 0; rs_ < REP_SYNC; ++rs_) { XcdBarrier xb_; xb_.bar = (unsigned*)A_WS; xb_.x = xb_xcc_id(); xb_.st = (volatile LAS unsigned*)(lds + 147456) + 8; xcd_barrier(xb_); } } ++step; } while (0)

    if (RUN()) { PH_BEGIN();
        for (int i = bx * 512 + tid; i < 65536; i += G * 512) RK2P[i] = 0.f;
        for (int rp_ = 0; rp_ < ((PROBE_ID == 6) ? 2 : 1); ++rp_) phase_convert(lds, gw, NGW, wave, lane, A_IN(2), A_IN(9), A_IN(11), A_IN(12), ws);
        for (int rp_ = 0; rp_ < REP_RMS; ++rp_) phase_rms_gates(lds, tid, bx, G, wave, lane, x_in, A_IN(1), A_IN(2), A_IN(3), XN, GATES, RSTD1P);
    }
    SEAM();
    for (int l = 0; l < 2; ++l) {
        for (int hf = 0; hf < 2; ++hf) {
            if (RUN()) { PH_BEGIN();
                pg8::Gemm g{XN + (size_t)hf * HTOK * DM, (const bf16*)(ws + WS_WIN) + (size_t)l * 8192 * 1024, HTOK, 8192, DM};
                pg8::StaticOrder S; S.init(HTOK, 8192, G, bx);
                pg8::EpiInProj E{Pb, VtA, VtB, (bf16*)(A_WS + WS_KF), RK2P, RSTD1P + hf * HTOK, lds + 131072};
                for (int rp_ = 0; rp_ < REP_GEMM; ++rp_) pg8::gemm_phase<pg8::EpiInProj, pg8::StaticOrder, true, true>(lds, g, S, E);
            }
            SEAM();
            if (RUN()) { PH_BEGIN();
                for (int rp_ = 0; rp_ < REP_MA; ++rp_) for (int u = GWV(); u < 2048; u += NGW) mlstm_a_unit(u, hf, lane, scr, Pb, VtA, SL, GATES, MLOC, BLAST, NLOC, A_IN(5) + (size_t)l * 4096, RK2P);
            }
            SEAM();
            if (RUN()) { PH_BEGIN();
                phase_scan(lds, bx, G, tid, hf, SL, MLOC, BLAST, M0, NLOC);
                if (hf == 1) for (int i = bx * 512 + tid; i < NTOK; i += G * 512) RSQ[i] = 0.f;
            }
            if (RUN()) { PH_BEGIN();
                for (int rp_ = REP_SB - 1; rp_ >= 0; --rp_) for (int u = GWV(); u < 2048; u += NGW) sb_unit(u, lane, scr, Pb, (const bf16*)(A_WS + WS_KF), RK2P, VtB, A_IN(7) + (size_t)l * 128, A_IN(8) + (size_t)l * 128, rp_ ? (bf16*)(A_WS + WS_END) : (bf16*)nullptr);
            }
            SEAM();
            if (RUN()) { PH_BEGIN();
                for (int i = bx * 512 + tid; i < 65536; i += G * 512) RK2P[i] = 0.f;
                for (int rp_ = 0; rp_ < REP_MC; ++rp_) for (int u = GWV(); u < 2048; u += NGW) mlstm_c_unit(u, hf, lane, scr, Pb, VtA, SL, GATES, M0, NLOC, A_IN(5) + (size_t)l * 4096, A_IN(6) + (size_t)l * 1024, A_IN(4) + (size_t)l * 2048, XN);
            }
            SEAM();
        }
        if (RUN()) { PH_BEGIN();
            pg8::Gemm g{XN, (const bf16*)(ws + WS_WOUT) + (size_t)l * 1024 * 1024, NTOK, DM, DM};
            pg8::StaticOrder S; S.init(NTOK, DM, G, bx);
            const float* xres = (l == 0) ? x_in : (const float*)xout;
            pg8::EpiResNorm E{xres, xout, DM, (bf16*)(A_WS + WS_AN), A_IN(10) + (size_t)l * DM, RSQ};
            pg8::gemm_phase<pg8::EpiResNorm, pg8::StaticOrder, false, true>(lds, g, S, E);
        }
        SEAM();
        if (RUN()) { PH_BEGIN();
            pg8::Gemm g{(const bf16*)(A_WS + WS_AN), (const bf16*)(ws + WS_WUP) + (size_t)l * 4096 * 1024, NTOK, DFF, DM};
            pg8::StaticOrder S; S.init(NTOK, DFF, G, bx);
            pg8::EpiRelu2N E{(bf16*)(A_WS + WS_HID), DFF, RSQ, 1.0f / DM, EPS};
            for (int rp_ = 0; rp_ < REP_GEMM; ++rp_) pg8::gemm_phase<pg8::EpiRelu2N, pg8::StaticOrder, true, true>(lds, g, S, E);
        }
        SEAM();
        if (RUN()) { PH_BEGIN();
            pg8::Gemm g{(const bf16*)(A_WS + WS_HID), (const bf16*)(ws + WS_WDN) + (size_t)l * 1024 * 4096, NTOK, DM, DFF};
            pg8::StaticOrder S; S.init(NTOK, DM, G, bx);
            pg8::EpiRes E{xout, xout, DM};
            pg8::gemm_phase<pg8::EpiRes, pg8::StaticOrder, false, true>(lds, g, S, E);
        }
        SEAM();
        if (l == 0) {
            if (RUN()) { PH_BEGIN(); for (int rp_ = 0; rp_ < REP_RMS; ++rp_) phase_rms_gates(lds, tid, bx, G, wave, lane, xout, A_IN(1) + DM, A_IN(2) + (size_t)DM * INC, A_IN(3) + 16, XN, GATES, RSTD1P); }
            SEAM();
        }
    }
}
#undef XN
#undef Pb
#undef VtA
#undef VtB
#undef SL
#undef GATES
#undef MLOC
#undef BLAST
#undef M0
#undef NLOC
#undef RSQ
#undef RSTD1P
#undef RK2P
#undef xout
#undef x_in
#undef ws
constexpr int N_STEPS = 1 + 2 * (8 + 3) + 1;

#ifndef MK_MULTI
#define MK_MULTI 0
#endif
extern "C" void kernel_launch(void* const* d_in, const int* in_sizes, int n_in, void* d_out, int out_size, void* d_ws, size_t ws_size, hipStream_t stream) {
    static int grid = 0;
    if (grid == 0) {
        if (n_in != 13 || out_size != NTOK * DM || ws_size < WS_TOP) { fprintf(stderr, "kernel_launch: unexpected shapes (n_in %d out %d ws %zu)\n", n_in, out_size, ws_size); grid = -1; return; }
        int dev = 0, cus = 0, per_cu = 0;
        hipGetDevice(&dev);
        hipDeviceGetAttribute(&cus, hipDeviceAttributeMultiprocessorCount, dev);
        if (hipFuncSetAttribute((const void*)fwd_kernel, hipFuncAttributeMaxDynamicSharedMemorySize, LDS_BYTES) != hipSuccess) { fprintf(stderr, "kernel_launch: hipFuncSetAttribute failed\n"); grid = -1; return; }
        if (hipOccupancyMaxActiveBlocksPerMultiprocessor(&per_cu, (const void*)fwd_kernel, 512, LDS_BYTES) != hipSuccess || per_cu < 1) { fprintf(stderr, "kernel_launch: occupancy query says %d\n", per_cu); per_cu = 1; }
        (void)hipGetLastError();
        grid = cus * 1;
        fprintf(stderr, "kernel_launch: grid %d (cus %d, per_cu %d)\n", grid, cus, per_cu);
    }
    if (grid < 0) return;
    if (hipMemsetAsync(d_ws, 0, 16384, stream) != hipSuccess) { fprintf(stderr, "kernel_launch: hipMemsetAsync failed\n"); return; }
    Args a{};
    for (int i = 0; i < 13; ++i) a.in[i] = (const float*)d_in[i];
    a.out = (float*)d_out; a.ws = (unsigned char*)d_ws;
#if MK_MULTI
    for (int s = 0; s < N_STEPS; ++s) { a.ph_lo = s; a.ph_hi = s + 1; hipLaunchKernelGGL(fwd_kernel, dim3(grid), dim3(512), LDS_BYTES, stream, a); }
#else
    a.ph_lo = 0; a.ph_hi = N_STEPS;
    void* args[] = {&a};
    hipError_t e = hipLaunchCooperativeKernel((const void*)fwd_kernel, dim3(grid), dim3(512), args, LDS_BYTES, stream);
    if (e != hipSuccess) fprintf(stderr, "kernel_launch: cooperative launch failed: %s (grid %d)\n", hipGetErrorString(e), grid);
#endif
}
```

```cpp
#include <hip/hip_runtime.h>
#include <hip/hip_cooperative_groups.h>
#include <cstdio>
#include <cstdint>
namespace cg = cooperative_groups;
namespace pg8 {
#define PG8_LAS __attribute__((address_space(3)))
typedef unsigned short bf16_t;
typedef short bf16x8 __attribute__((ext_vector_type(8)));
typedef float f32x4 __attribute__((ext_vector_type(4)));
typedef unsigned u32x4 __attribute__((ext_vector_type(4)));
constexpr int BM = 256, BK = 64, HALF = 128, HTB = HALF * BK * 2  , STAGE_BYTES = 8 * HTB, NXCD = 8, WGM = 4  ;

__host__ __device__ __forceinline__ int lds_byte(int r, int c) { const int st = (r >> 4) * 2 + (c >> 5), rr = r & 15, cc = c & 31, ob = rr * 64 + cc * 2; return st * 1024 + (ob ^ (((ob >> 9) & 1) << 5)); }
__host__ __device__ __forceinline__ void stage_rc(int b, int& R, int& C) { const int st = b / 1024, sb = b % 1024, swz = sb ^ (((sb >> 9) & 1) << 5); R = (st >> 1) * 16 + swz / 64; C = (st & 1) * 32 + (swz % 64) / 2; }
__host__ __device__ __forceinline__ int perm32(int rho) { const int n = rho >> 4, i = rho & 15; return 8 * (i >> 2) + 4 * n + (i & 3); }

struct Unit { int pm, pn; };
struct Gemm { const bf16_t* A; const bf16_t* Bt; int M, N, K; };

struct StaticOrder {
    int nM, nN, nwg, G, c;
    __host__ __device__ void init(int M, int N, int G_, int c_) { nM = M / BM; nN = N / BM; nwg = nM * nN; G = G_; c = c_; }
    __host__ __device__ bool next(int i, Unit& u) const {
        const long L = (long)i * G + c; if (L >= nwg) return false;
        int wgid = (int)L; { const int q = nwg / NXCD, r = nwg % NXCD, xcd = wgid % NXCD, off = wgid / NXCD; wgid = (xcd < r ? xcd * (q + 1) : r * (q + 1) + (xcd - r) * q) + off; }
        const int nig = WGM * nN, gid = wgid / nig, fm = gid * WGM, gsz = (nM - fm) < WGM ? (nM - fm) : WGM;
        u.pm = fm + ((wgid % nig) % gsz); u.pn = (wgid % nig) / gsz; return true;
    }
    __device__ __forceinline__ void a_ready(const Unit&) const {}
    __device__ __forceinline__ void done(const Unit&) const {}
};

__device__ __forceinline__ unsigned cvt_pk_bf16(float lo, float hi) { unsigned r; asm volatile("v_cvt_pk_bf16_f32 %0, %1, %2" : "=v"(r) : "v"(lo), "v"(hi)); return r; }
typedef float f32x2 __attribute__((ext_vector_type(2)));
__device__ __forceinline__ void st16_wt(void* p, u32x4 v) { *(u32x4*)p = v; }
__device__ __forceinline__ void st16_wt_f(void* p, f32x4 v) { *(f32x4*)p = v; }
__device__ __forceinline__ bf16_t f2bf1(float f) { unsigned u = __builtin_bit_cast(unsigned, f); return (bf16_t)((u + 0x7fffu + ((u >> 16) & 1u)) >> 16); }
struct EpiInProj {
    static constexpr bool PERM = true, AFTER_DRAIN = false;
    bf16_t* P; bf16_t* VtA; bf16_t* VtB; bf16_t* Kf; float* rk2  ; const float* rstd;
    PG8_LAS unsigned char* ldx;
    __device__ __forceinline__ void operator()(const f32x4 (&acc)[2][2][4][2], const Unit& u, int wr, int wc, int fr, int fq) const {
        const int pn = u.pn; const int row0 = u.pm * BM + wr * 64 + fr;
        float rsv[2][4];
#pragma unroll
        for (int ai = 0; ai < 2; ++ai)
#pragma unroll
            for (int m = 0; m < 4; ++m) rsv[ai][m] = rstd[row0 + ai * HALF + m * 16];
        const bool isv = (pn >= 4 && pn < 8) || (pn >= 20 && pn < 24);
        const bool isk = (pn >= 16 && pn < 20);
        if (isk) {
#pragma unroll
            for (int ai = 0; ai < 2; ++ai)
#pragma unroll
                for (int m = 0; m < 4; ++m) { const int r = row0 + ai * HALF + m * 16; const int bl = r >> 12, s = r & 4095; const float rs = rsv[ai][m];
#pragma unroll
                    for (int bj = 0; bj < 2; ++bj) { const f32x4 v0 = acc[ai][bj][m][0] * rs, v1 = acc[ai][bj][m][1] * rs;
                        u32x4 w; w.x = cvt_pk_bf16(v0[0], v0[1]); w.y = cvt_pk_bf16(v0[2], v0[3]); w.z = cvt_pk_bf16(v1[0], v1[1]); w.w = cvt_pk_bf16(v1[2], v1[3]);
                        const int hh = (pn - 16) * 2 + bj, st = wc * 2 + (fq >> 1), hi = fq & 1;
                        { const int lane_ = fq * 16 + fr; float p = ((v0[0] * v0[0] + v0[1] * v0[1]) + (v0[2] * v0[2] + v0[3] * v0[3])) + ((v1[0] * v1[0] + v1[1] * v1[1]) + (v1[2] * v1[2] + v1[3] * v1[3]));
                          p += __builtin_bit_cast(float, __builtin_amdgcn_ds_bpermute((lane_ ^ 16) << 2, __builtin_bit_cast(int, p)));
                          p += __builtin_bit_cast(float, __builtin_amdgcn_ds_bpermute((lane_ ^ 32) << 2, __builtin_bit_cast(int, p)));
                          if (fq == 0) unsafeAtomicAdd(rk2 + (size_t)(bl * 8 + hh) * 4096 + s, p); }
                        st16_wt(Kf + ((size_t)(((bl * 8 + hh) * 128 + (s >> 5)) * 8 + st)) * 512 + (s & 31) * 16 + hi * 8, w); } }
        } else if (!isv) {
            const int colt = pn < 4 ? pn * 256 : pn < 12 ? (pn - 8) * 256 + 1024 : pn < 16 ? (pn - 12) * 256 + 2048 : (pn - 24) * 256 + 3072;
            const int col0 = colt + wc * 32 + 8 * fq;
#pragma unroll
            for (int ai = 0; ai < 2; ++ai)
#pragma unroll
                for (int m = 0; m < 4; ++m) { bf16_t* rowp = P + (size_t)(row0 + ai * HALF + m * 16) * 5120 + col0; const float rs = rsv[ai][m];
#pragma unroll
                    for (int bj = 0; bj < 2; ++bj) { const f32x4 v0 = acc[ai][bj][m][0] * rs, v1 = acc[ai][bj][m][1] * rs;
                        u32x4 w; w.x = cvt_pk_bf16(v0[0], v0[1]); w.y = cvt_pk_bf16(v0[2], v0[3]); w.z = cvt_pk_bf16(v1[0], v1[1]); w.w = cvt_pk_bf16(v1[2], v1[3]);
                        st16_wt(rowp + bj * HALF, w); } }
        } else {
            bf16_t* Vt = pn < 8 ? VtA : VtB;
            const int hb = (pn < 8 ? pn - 4 : pn - 20) * 2;
            const int lane_ = fq * 16 + fr;
            PG8_LAS bf16_t* tl = (PG8_LAS bf16_t*)(ldx + (wr * 4 + wc) * 2048);
            const int pk = ((fr >> 2) & 1) * 8 + ((fr >> 3) & 1) * 4 + (fr & 3);
#pragma unroll
            for (int ai = 0; ai < 2; ++ai)
#pragma unroll
                for (int m = 0; m < 4; ++m) { const int r0 = u.pm * BM + wr * 64 + ai * HALF + m * 16; const int bl = r0 >> 12, s0 = r0 & 4095; const float rs = rsv[ai][m];
#pragma unroll
                    for (int bj = 0; bj < 2; ++bj) {
#pragma unroll
                        for (int n = 0; n < 2; ++n)
#pragma unroll
                            for (int e = 0; e < 4; ++e) tl[(8 * fq + 4 * n + e) * 16 + pk] = f2bf1(acc[ai][bj][m][n][e] * rs);
                        asm volatile("s_waitcnt lgkmcnt(0)" ::: "memory");
                        const u32x4 v = *(const PG8_LAS u32x4*)(tl + lane_ * 8);
                        asm volatile("s_waitcnt lgkmcnt(0)" ::: "memory");
                        *(u32x4*)(Vt + ((size_t)(((bl * 8 + hb + bj) * 128 + (s0 >> 5)) * 8 + wc * 2 + ((s0 >> 4) & 1))) * 512 + lane_ * 8) = v; } }
        }
    }
};
struct EpiRelu2 {
    static constexpr bool PERM = true, AFTER_DRAIN = false;
    bf16_t* O; int ldc;
    __device__ __forceinline__ void operator()(const f32x4 (&acc)[2][2][4][2], const Unit& u, int wr, int wc, int fr, int fq) const {
        const int row0 = u.pm * BM + wr * 64 + fr; const int col0 = u.pn * BM + wc * 32 + 8 * fq;
#pragma unroll
        for (int ai = 0; ai < 2; ++ai)
#pragma unroll
            for (int m = 0; m < 4; ++m) { bf16_t* rowp = O + (size_t)(row0 + ai * HALF + m * 16) * ldc + col0;
#pragma unroll
                for (int bj = 0; bj < 2; ++bj) { f32x4 v0 = acc[ai][bj][m][0], v1 = acc[ai][bj][m][1];
#pragma unroll
                    for (int e = 0; e < 4; ++e) { const float a = fmaxf(v0[e], 0.f), b = fmaxf(v1[e], 0.f); v0[e] = a * a; v1[e] = b * b; }
                    u32x4 w; w.x = cvt_pk_bf16(v0[0], v0[1]); w.y = cvt_pk_bf16(v0[2], v0[3]); w.z = cvt_pk_bf16(v1[0], v1[1]); w.w = cvt_pk_bf16(v1[2], v1[3]);
                    st16_wt(rowp + bj * HALF, w); } }
    }
};
struct EpiRes {
    static constexpr bool PERM = true, AFTER_DRAIN = false;
    const float* base; float* out; int ldc;
    __device__ __forceinline__ void operator()(const f32x4 (&acc)[2][2][4][2], const Unit& u, int wr, int wc, int fr, int fq) const {
        const int col0 = u.pn * BM + wc * 32 + 8 * fq;
#pragma unroll
        for (int ai = 0; ai < 2; ++ai) {
            f32x4 bs[4][2][2];
#pragma unroll
            for (int m = 0; m < 4; ++m) { const size_t off = (size_t)(u.pm * BM + ai * HALF + wr * 64 + m * 16 + fr) * ldc + col0;
#pragma unroll
                for (int bj = 0; bj < 2; ++bj)
#pragma unroll
                    for (int n = 0; n < 2; ++n) bs[m][bj][n] = *(const f32x4*)(base + off + bj * HALF + n * 4); }
#pragma unroll
            for (int m = 0; m < 4; ++m) { const size_t off = (size_t)(u.pm * BM + ai * HALF + wr * 64 + m * 16 + fr) * ldc + col0;
#pragma unroll
                for (int bj = 0; bj < 2; ++bj)
#pragma unroll
                    for (int n = 0; n < 2; ++n) *(f32x4*)(out + off + bj * HALF + n * 4) = bs[m][bj][n] + acc[ai][bj][m][n]; }
        }
    }
};
struct EpiResProbe {
    static constexpr bool PERM = false, AFTER_DRAIN = false;
    const float* base; float* out; int ldc;
    __device__ __forceinline__ void operator()(const f32x4 (&acc)[2][2][4][2], const Unit& u, int wr, int wc, int fr, int fq) const {
        const int col0 = u.pn * BM + wc * 32 + 4 * fq;
#pragma unroll
        for (int ai = 0; ai < 2; ++ai)
#pragma unroll
            for (int m = 0; m < 4; ++m) { const int r = u.pm * BM + ai * HALF + wr * 64 + m * 16 + fr; const size_t off = (size_t)r * ldc + col0; const size_t off2 = (size_t)(r & 2047) * ldc + col0;
#pragma unroll
                for (int bj = 0; bj < 2; ++bj)
#pragma unroll
                    for (int n = 0; n < 2; ++n) { const f32x4 bs = *(const f32x4*)(base + off + bj * HALF + n * 16); *(f32x4*)(out + off2 + bj * HALF + n * 16) = bs + acc[ai][bj][m][n]; } }
    }
};
struct EpiResNorm {
    static constexpr bool PERM = true, AFTER_DRAIN = false;
    const float* base; float* out; int ldc; bf16_t* An; const float* g; float* rsq;
    __device__ __forceinline__ void operator()(const f32x4 (&acc)[2][2][4][2], const Unit& u, int wr, int wc, int fr, int fq) const {
        const int col0 = u.pn * BM + wc * 32 + 8 * fq; const int lane = fq * 16 + fr;
        f32x4 gv[2][2];
#pragma unroll
        for (int bj = 0; bj < 2; ++bj)
#pragma unroll
            for (int n = 0; n < 2; ++n) gv[bj][n] = *(const f32x4*)(g + col0 + bj * HALF + n * 4);
#pragma unroll
        for (int ai = 0; ai < 2; ++ai) {
            f32x4 bs[4][2][2];
#pragma unroll
            for (int m = 0; m < 4; ++m) { const size_t off = (size_t)(u.pm * BM + ai * HALF + wr * 64 + m * 16 + fr) * ldc + col0;
#pragma unroll
                for (int bj = 0; bj < 2; ++bj)
#pragma unroll
                    for (int n = 0; n < 2; ++n) bs[m][bj][n] = *(const f32x4*)(base + off + bj * HALF + n * 4); }
#pragma unroll
            for (int m = 0; m < 4; ++m) { const int r = u.pm * BM + ai * HALF + wr * 64 + m * 16 + fr; const size_t off = (size_t)r * ldc + col0; float ss = 0.f;
#pragma unroll
                for (int bj = 0; bj < 2; ++bj) { u32x4 pk;
#pragma unroll
                    for (int n = 0; n < 2; ++n) { const f32x4 o = bs[m][bj][n] + acc[ai][bj][m][n];
                        *(f32x4*)(out + off + bj * HALF + n * 4) = o; ss += (o[0] * o[0] + o[1] * o[1]) + (o[2] * o[2] + o[3] * o[3]);
                        const f32x4 w = o * gv[bj][n]; pk[2 * n] = cvt_pk_bf16(w[0], w[1]); pk[2 * n + 1] = cvt_pk_bf16(w[2], w[3]); }
                    *(u32x4*)(An + off + bj * HALF) = pk; }
                ss += __builtin_bit_cast(float, __builtin_amdgcn_ds_bpermute((lane ^ 16) << 2, __builtin_bit_cast(int, ss)));
                ss += __builtin_bit_cast(float, __builtin_amdgcn_ds_bpermute((lane ^ 32) << 2, __builtin_bit_cast(int, ss)));
                if (fq == 0) unsafeAtomicAdd(rsq + r, ss); }
        }
    }
};
struct EpiRelu2N {
    static constexpr bool PERM = true, AFTER_DRAIN = false;
    bf16_t* O; int ldc; const float* rsq; float invk, eps;
    __device__ __forceinline__ void operator()(const f32x4 (&acc)[2][2][4][2], const Unit& u, int wr, int wc, int fr, int fq) const {
        const int row0 = u.pm * BM + wr * 64 + fr; const int col0 = u.pn * BM + wc * 32 + 8 * fq;
        float rq[2][4];
#pragma unroll
        for (int ai = 0; ai < 2; ++ai)
#pragma unroll
            for (int m = 0; m < 4; ++m) rq[ai][m] = rsq[row0 + ai * HALF + m * 16];
#pragma unroll
        for (int ai = 0; ai < 2; ++ai)
#pragma unroll
            for (int m = 0; m < 4; ++m) { const int r = row0 + ai * HALF + m * 16; bf16_t* rowp = O + (size_t)r * ldc + col0;
                const float rstd = 1.0f / sqrtf(rq[ai][m] * invk + eps);
#pragma unroll
                for (int bj = 0; bj < 2; ++bj) { f32x4 v0 = acc[ai][bj][m][0], v1 = acc[ai][bj][m][1];
#pragma unroll
                    for (int e = 0; e < 4; ++e) { const float a = fmaxf(v0[e], 0.f) * rstd, b = fmaxf(v1[e], 0.f) * rstd; v0[e] = a * a; v1[e] = b * b; }
                    u32x4 w; w.x = cvt_pk_bf16(v0[0], v0[1]); w.y = cvt_pk_bf16(v0[2], v0[3]); w.z = cvt_pk_bf16(v1[0], v1[1]); w.w = cvt_pk_bf16(v1[2], v1[3]);
                    st16_wt(rowp + bj * HALF, w); } }
    }
};
template <class Epi, class Sched, bool ALIGN_EPI = false, bool SP2 = false>
__device__ __forceinline__ void gemm_phase(PG8_LAS unsigned char* lds, const Gemm g, const Sched& S, const Epi& E) {
    int tid_ = threadIdx.x; asm volatile("" : "+v"(tid_));
    const int tid = tid_, wid = __builtin_amdgcn_readfirstlane(tid >> 6), lane = tid & 63, wr = wid >> 2, wc = wid & 3, fr = lane & 15, fq = lane >> 4;
    const int K = g.K, nt = K / BK;
    unsigned voffA[2], voffB[2];
#pragma unroll
    for (int i = 0; i < 2; ++i) { int R, C; stage_rc(tid * 16 + i * 8192, R, C); const int Rb = Epi::PERM ? ((R & ~31) + perm32(R & 31)) : R;
        voffA[i] = (unsigned)(R * K + C) * 2u; voffB[i] = (unsigned)(Rb * K + C) * 2u; }
    const size_t kstep = (size_t)(BK * 2);
    const size_t hstep = (size_t)HALF * K * 2;
    const size_t tstep = 2 * hstep;
    const unsigned ldsw = (unsigned)wid * 1024u;
    const int aoff = lds_byte(wr * 64 + fr, fq * 8), boff = lds_byte(wc * 32 + fr, fq * 8);
#define PG8_SA(b, h) (((b) * 2 + (h)) * HTB)
#define PG8_SB(b, h) ((4 + (b) * 2 + (h)) * HTB)
#define PG8_STAGE(bufoff, gbase, voff) do { _Pragma("unroll") for (int _i = 0; _i < 2; ++_i) \
        __builtin_amdgcn_global_load_lds((const unsigned*)((const char*)(gbase) + (voff)[_i]), (PG8_LAS unsigned*)(lds + (bufoff) + ldsw + _i * 8192), 16, 0, 0); } while (0)
#define PG8_LDA(dst, b, h) do { _Pragma("unroll") for (int m = 0; m < 4; ++m) _Pragma("unroll") for (int k = 0; k < 2; ++k) dst[m][k] = *(const PG8_LAS bf16x8*)(lds + PG8_SA(b, h) + aoff + m * 2048 + k * 1024); } while (0)
#define PG8_LDB(dst, b, h) do { _Pragma("unroll") for (int n = 0; n < 2; ++n) _Pragma("unroll") for (int k = 0; k < 2; ++k) dst[n][k] = *(const PG8_LAS bf16x8*)(lds + PG8_SB(b, h) + boff + n * 2048 + k * 1024); } while (0)
#define PG8_MMA(ai, bj, At, Bt) do { __builtin_amdgcn_s_setprio(1); _Pragma("unroll") for (int m = 0; m < 4; ++m) _Pragma("unroll") for (int n = 0; n < 2; ++n) _Pragma("unroll") for (int k = 0; k < 2; ++k) \
        acc[ai][bj][m][n] = __builtin_amdgcn_mfma_f32_16x16x32_bf16(Bt[n][k], At[m][k], acc[ai][bj][m][n], 0, 0, 0); __builtin_amdgcn_s_setprio(0); } while (0)
#define PG8_WAIT_V(n) asm volatile("s_waitcnt vmcnt(" #n ")" ::: "memory")
#define PG8_WAIT_L(n) asm volatile("s_waitcnt lgkmcnt(" #n ")" ::: "memory")
#define PG8_BAR __builtin_amdgcn_s_barrier()
#define PG8_SCHED __builtin_amdgcn_sched_barrier(0)
    Unit cur, nxt; int ui = 0;
    if (!S.next(0, cur)) return;
    f32x4 acc[2][2][4][2];
#pragma unroll
    for (int a = 0; a < 2; ++a)
#pragma unroll
        for (int b = 0; b < 2; ++b)
#pragma unroll
            for (int m = 0; m < 4; ++m)
#pragma unroll
                for (int n = 0; n < 2; ++n) acc[a][b][m][n] = (f32x4){0.f, 0.f, 0.f, 0.f};
    bf16x8 At[4][2], B0[2][2], B1[2][2];
    const char* cA = (const char*)g.A + (size_t)cur.pm * tstep; const char* cB = (const char*)g.Bt + (size_t)cur.pn * tstep;
    S.a_ready(cur);
    if constexpr (SP2) {
        PG8_STAGE(PG8_SB(0, 0), cB, voffB); PG8_STAGE(PG8_SB(0, 1), cB + hstep, voffB); PG8_STAGE(PG8_SA(0, 0), cA, voffA); PG8_STAGE(PG8_SA(0, 1), cA + hstep, voffA);
        if (wr == 1) PG8_BAR;
        PG8_WAIT_V(2); PG8_BAR;
        PG8_STAGE(PG8_SB(1, 0), cB + kstep, voffB); PG8_STAGE(PG8_SA(1, 0), cA + kstep, voffA); PG8_STAGE(PG8_SB(1, 1), cB + hstep + kstep, voffB);
        PG8_WAIT_V(6); PG8_BAR;
    } else {
        PG8_STAGE(PG8_SB(0, 0), cB, voffB); PG8_STAGE(PG8_SA(0, 0), cA, voffA); PG8_STAGE(PG8_SB(0, 1), cB + hstep, voffB); PG8_STAGE(PG8_SA(0, 1), cA + hstep, voffA);
        if (wr == 1) PG8_BAR;
        PG8_WAIT_V(4); PG8_BAR;
        PG8_STAGE(PG8_SB(1, 0), cB + kstep, voffB); PG8_STAGE(PG8_SA(1, 0), cA + kstep, voffA); PG8_STAGE(PG8_SB(1, 1), cB + hstep + kstep, voffB);
        PG8_WAIT_V(6); PG8_BAR;
    }
    for (;;) {
        const bool has_next = S.next(ui + 1, nxt);
        const char* nA = has_next ? (const char*)g.A + (size_t)nxt.pm * tstep : cA; const char* nB = has_next ? (const char*)g.Bt + (size_t)nxt.pn * tstep : cB;
        for (int t = 0; t < nt; t += 2) {
            const bool last = (t == nt - 2);
            const char* a1 = cA + (size_t)(t + 1) * kstep;
            const char* a2 = last ? nA : cA + (size_t)(t + 2) * kstep; const char* b2 = last ? nB : cB + (size_t)(t + 2) * kstep;
            const char* a3 = a2 + kstep; const char* b3 = b2 + kstep;
            if (last && has_next) S.a_ready(nxt);
            if constexpr (SP2) {
            PG8_LDB(B0, 0, 0); PG8_LDB(B1, 0, 1); PG8_SCHED; PG8_LDA(At, 0, 0); PG8_STAGE(PG8_SA(1, 1), a1 + hstep, voffA);
            PG8_WAIT_V(8); PG8_WAIT_L(0); PG8_BAR; PG8_MMA(0, 0, At, B0); PG8_MMA(0, 1, At, B1); PG8_BAR; PG8_SCHED;
            PG8_LDA(At, 0, 1); PG8_STAGE(PG8_SB(0, 0), b2, voffB); PG8_STAGE(PG8_SB(0, 1), b2 + hstep, voffB); PG8_STAGE(PG8_SA(0, 0), a2, voffA);
            PG8_WAIT_V(8); PG8_WAIT_L(0); PG8_BAR; PG8_MMA(1, 0, At, B0); PG8_MMA(1, 1, At, B1); PG8_BAR; PG8_SCHED;
            PG8_LDB(B0, 1, 0); PG8_LDB(B1, 1, 1); PG8_SCHED; PG8_LDA(At, 1, 0); PG8_STAGE(PG8_SA(0, 1), a2 + hstep, voffA);
            PG8_WAIT_V(8); PG8_WAIT_L(0); PG8_BAR; PG8_MMA(0, 0, At, B0); PG8_MMA(0, 1, At, B1); PG8_BAR; PG8_SCHED;
            PG8_LDA(At, 1, 1); PG8_STAGE(PG8_SB(1, 0), b3, voffB); PG8_STAGE(PG8_SB(1, 1), b3 + hstep, voffB); PG8_STAGE(PG8_SA(1, 0), a3, voffA);
            PG8_WAIT_V(8); PG8_WAIT_L(0); PG8_BAR; PG8_MMA(1, 0, At, B0); PG8_MMA(1, 1, At, B1); PG8_BAR; PG8_SCHED;
            } else {
            PG8_LDB(B0, 0, 0); PG8_SCHED; PG8_LDA(At, 0, 0); PG8_STAGE(PG8_SA(1, 1), a1 + hstep, voffA);
            PG8_WAIT_L(8); PG8_BAR; PG8_WAIT_L(0); PG8_MMA(0, 0, At, B0); PG8_BAR; PG8_SCHED;
            PG8_LDB(B1, 0, 1); PG8_STAGE(PG8_SB(0, 0), b2, voffB);
            PG8_BAR; PG8_WAIT_L(0); PG8_MMA(0, 1, At, B1); PG8_BAR;
            PG8_LDA(At, 0, 1); PG8_STAGE(PG8_SA(0, 0), a2, voffA);
            PG8_BAR; PG8_WAIT_L(0); PG8_MMA(1, 0, At, B0); PG8_BAR; PG8_SCHED;
            PG8_STAGE(PG8_SB(0, 1), b2 + hstep, voffB);
            PG8_WAIT_V(6); PG8_BAR; PG8_MMA(1, 1, At, B1); PG8_BAR;
            PG8_LDB(B0, 1, 0); PG8_SCHED; PG8_LDA(At, 1, 0); PG8_STAGE(PG8_SA(0, 1), a2 + hstep, voffA);
            PG8_WAIT_L(8); PG8_BAR; PG8_WAIT_L(0); PG8_MMA(0, 0, At, B0); PG8_BAR; PG8_SCHED;
            PG8_LDB(B1, 1, 1); PG8_STAGE(PG8_SB(1, 0), b3, voffB);
            PG8_BAR; PG8_WAIT_L(0); PG8_MMA(0, 1, At, B1); PG8_BAR;
            PG8_LDA(At, 1, 1); PG8_STAGE(PG8_SA(1, 0), a3, voffA);
            PG8_BAR; PG8_WAIT_L(0); PG8_MMA(1, 0, At, B0); PG8_BAR; PG8_SCHED;
            PG8_STAGE(PG8_SB(1, 1), b3 + hstep, voffB);
            PG8_WAIT_V(6); PG8_BAR; PG8_MMA(1, 1, At, B1); PG8_BAR;
            }
        }
        if constexpr (ALIGN_EPI) { if (wr == 0) PG8_BAR; }
        if constexpr (!Epi::AFTER_DRAIN) { E(acc, cur, wr, wc, fr, fq); S.done(cur); }
        if (!has_next) break;
#pragma unroll
        for (int a = 0; a < 2; ++a)
#pragma unroll
            for (int b = 0; b < 2; ++b)
#pragma unroll
                for (int m = 0; m < 4; ++m)
#pragma unroll
                    for (int n = 0; n < 2; ++n) acc[a][b][m][n] = (f32x4){0.f, 0.f, 0.f, 0.f};
        cur = nxt; cA = nA; cB = nB; ++ui;
        if constexpr (ALIGN_EPI) { if (wr == 1) PG8_BAR; }
    }
    PG8_WAIT_V(0);
    if constexpr (!ALIGN_EPI) { if (wr == 0) PG8_BAR; }
    PG8_BAR;
    if constexpr (Epi::AFTER_DRAIN) { E.fused(acc, cur, wr, wc, fr, fq, lds, wid, lane); S.done(cur); }
#undef PG8_SA
#undef PG8_SB
#undef PG8_STAGE
#undef PG8_LDA
#undef PG8_LDB
#undef PG8_MMA
#undef PG8_WAIT_V
#undef PG8_WAIT_L
#undef PG8_BAR
#undef PG8_SCHED
}
}
#define DI __device__ __forceinline__
#define LAS __attribute__((address_space(3)))
typedef unsigned short bf16;
typedef short bf16x8 __attribute__((ext_vector_type(8)));
typedef short s16x4 __attribute__((ext_vector_type(4)));
typedef float f32x4 __attribute__((ext_vector_type(4)));
typedef float f32x16 __attribute__((ext_vector_type(16)));
typedef unsigned u32x2 __attribute__((ext_vector_type(2)));
typedef unsigned u32x4 __attribute__((ext_vector_type(4)));
typedef float f32x2_t __attribute__((ext_vector_type(2)));
typedef __bf16 bf16x2_t __attribute__((ext_vector_type(2)));

constexpr int NTOK = 16384, DM = 1024, SEQ = 4096, DFF = 4096, INC = 8208, HTOK = 8192, PW = 5120;
constexpr int PC_QA = 0, PC_KA = 512, PC_OA = 1024, PC_QB = 2048, PC_GA = 3072, PC_GB = 4096;
constexpr float EPS = 1e-6f;
constexpr size_t MiB = 1u << 20;
constexpr size_t WS_GATES = 1 * MiB, WS_STATS = 2 * MiB, WS_WIN = 4 * MiB, WS_WOUT = 36 * MiB, WS_WUP = 40 * MiB, WS_WDN = 56 * MiB,
                 WS_XN = 72 * MiB, WS_P = 104 * MiB, WS_KF = 184 * MiB  , WS_VTA = 200 * MiB, WS_VTB = 216 * MiB, WS_SL = 232 * MiB, WS_END = 248 * MiB,
                 WS_HID = 72 * MiB  , WS_AN = 224 * MiB  , WS_TOP = 256 * MiB;
constexpr int LDS_BYTES = 147456 + 64;

DI float bf2f(short b) { return __uint_as_float(((unsigned)(unsigned short)b) << 16); }
DI unsigned pk2(float lo, float hi) { f32x2_t v = {lo, hi}; bf16x2_t b = __builtin_convertvector(v, bf16x2_t); return __builtin_bit_cast(unsigned, b); }
DI bf16x8 pack8(const float* v) { u32x4 p = {pk2(v[0], v[1]), pk2(v[2], v[3]), pk2(v[4], v[5]), pk2(v[6], v[7])}; return __builtin_bit_cast(bf16x8, p); }
DI float shx(float v, int o, int lane) { return __builtin_bit_cast(float, __builtin_amdgcn_ds_bpermute((lane ^ o) << 2, __builtin_bit_cast(int, v))); }
DI float shi(float v, int src) { return __builtin_bit_cast(float, __builtin_amdgcn_ds_bpermute(src << 2, __builtin_bit_cast(int, v))); }
DI float wave_sum(float v, int lane) {
#pragma unroll
    for (int o = 1; o < 64; o <<= 1) v += shx(v, o, lane);
    return v; }
DI float wave_max(float v, int lane) {
#pragma unroll
    for (int o = 1; o < 64; o <<= 1) v = fmaxf(v, shx(v, o, lane));
    return v; }
DI float scan_add(float v, int lane) {
#pragma unroll
    for (int o = 1; o < 64; o <<= 1) { const float t = shi(v, lane >= o ? lane - o : lane); if (lane >= o) v += t; }
    return v; }
DI float scan_max(float v, int lane) {
#pragma unroll
    for (int o = 1; o < 64; o <<= 1) { const float t = shi(v, lane >= o ? lane - o : lane); if (lane >= o) v = fmaxf(v, t); }
    return v; }
#define LDS_FENCE() asm volatile("s_waitcnt lgkmcnt(0)" ::: "memory")
DI float sigm(float x) { return __builtin_amdgcn_rcpf(1.f + __expf(-x)); }
DI float logsigmoid_(float x) { return fminf(x, 0.f) - log1pf(expf(-fabsf(x))); }
DI int crow(int r, int hi) { return (r & 3) + 8 * (r >> 2) + 4 * hi; }
#define MFMA32(a, b, c) __builtin_amdgcn_mfma_f32_32x32x16_bf16((a), (b), (c), 0, 0, 0)

DI void transpose_item(const float* W, int ldw, int srccol0, int k0, bf16* WT, int K, int dstrow0, LAS float* scr, int lane) {
#pragma unroll 16
    for (int i = 0; i < 32; ++i) { const int kk = 2 * i + (lane >> 5); scr[kk * 33 + (lane & 31)] = W[(size_t)(k0 + kk) * ldw + srccol0 + (lane & 31)]; }
    LDS_FENCE();
    const int c = lane & 7;
#pragma unroll
    for (int j = 0; j < 4; ++j) { const int n = (lane >> 3) + 8 * j; const LAS float* s = scr + (8 * c) * 33 + n;
        u32x4 o; o.x = pk2(s[0 * 33], s[1 * 33]); o.y = pk2(s[2 * 33], s[3 * 33]); o.z = pk2(s[4 * 33], s[5 * 33]); o.w = pk2(s[6 * 33], s[7 * 33]);
        *(u32x4*)(WT + (size_t)(dstrow0 + n) * K + k0 + 8 * c) = o; }
    LDS_FENCE();
}
DI void phase_convert(LAS unsigned char* lds, int gw, int NGW, int wave, int lane, const float* w_in, const float* w_out, const float* w_up, const float* w_down, unsigned char* ws) {
    LAS float* scr = (LAS float*)(lds + wave * 16384);
    constexpr int I_IN = 16 * 256, I_OUT = 16 * 32, I_UP = 16 * 128, I_DN = 64 * 32, I_L = I_IN + I_OUT + I_UP + I_DN;
    for (int it = gw; it < 2 * I_L; it += NGW) {
        const int l = it / I_L; int r = it % I_L;
        if (r < I_IN) { const int kb = r / 256, nb = r % 256, n0 = 32 * nb;
            transpose_item(w_in + (size_t)l * DM * INC, INC, n0 < 3072 ? n0 : n0 + 16, 64 * kb, (bf16*)(ws + WS_WIN) + (size_t)l * 8192 * 1024, 1024, n0, scr, lane); continue; }
        r -= I_IN;
        if (r < I_OUT) { const int kb = r / 32, nb = r % 32;
            transpose_item(w_out + (size_t)l * DM * DM, DM, 32 * nb, 64 * kb, (bf16*)(ws + WS_WOUT) + (size_t)l * 1024 * 1024, 1024, 32 * nb, scr, lane); continue; }
        r -= I_OUT;
        if (r < I_UP) { const int kb = r / 128, nb = r % 128;
            transpose_item(w_up + (size_t)l * DM * DFF, DFF, 32 * nb, 64 * kb, (bf16*)(ws + WS_WUP) + (size_t)l * 4096 * 1024, 1024, 32 * nb, scr, lane); continue; }
        r -= I_UP;
        { const int kb = r / 32, nb = r % 32;
            transpose_item(w_down + (size_t)l * DFF * DM, DM, 32 * nb, 64 * kb, (bf16*)(ws + WS_WDN) + (size_t)l * 1024 * 4096, 4096, 32 * nb, scr, lane); }
    }
}

constexpr int NR1 = 1;
DI float selv(bool c, float a, float b) { asm volatile("" : "+v"(a), "+v"(b)); return c ? a : b; }
DI float tsum16(float (&ga)[16], int lane) {
    float a8[8], a4[4], a2[2], a1;
    const bool b5 = lane & 32, b4 = lane & 16, b3 = lane & 8, b2 = lane & 4;
#pragma unroll
    for (int j = 0; j < 8; ++j) { const float snd = selv(b5, ga[j], ga[j + 8]), kp = selv(b5, ga[j + 8], ga[j]); a8[j] = kp + shx(snd, 32, lane); }
#pragma unroll
    for (int j = 0; j < 4; ++j) { const float snd = selv(b4, a8[j], a8[j + 4]), kp = selv(b4, a8[j + 4], a8[j]); a4[j] = kp + shx(snd, 16, lane); }
#pragma unroll
    for (int j = 0; j < 2; ++j) { const float snd = selv(b3, a4[j], a4[j + 2]), kp = selv(b3, a4[j + 2], a4[j]); a2[j] = kp + shx(snd, 8, lane); }
    { const float snd = selv(b2, a2[0], a2[1]), kp = selv(b2, a2[1], a2[0]); a1 = kp + shx(snd, 4, lane); }
    a1 += shx(a1, 2, lane); a1 += shx(a1, 1, lane);
    return a1;
}
typedef float f32x4m __attribute__((ext_vector_type(4)));
DI void phase_rms_gates(LAS unsigned char* lds, int tid, int bx, int G, int wave, int lane, const float* xsrc, const float* g, const float* w_in_l, const float* b_if_l, bf16* XN, float* GATES, float* RSTD1) {
    LAS bf16x8* hiL = (LAS bf16x8*)lds; LAS bf16x8* loL = hiL + 2048;
    __syncthreads();
    for (int idx = tid; idx < 2048; idx += 512) { const int n = idx & 15, k0 = (idx >> 4) * 8; float wv[8], wl_[8];
#pragma unroll
        for (int j = 0; j < 8; ++j) { const float w = w_in_l[(size_t)(k0 + j) * INC + 3072 + n] * g[k0 + j]; const unsigned hb = pk2(w, 0.f) & 0xffffu; wv[j] = __uint_as_float(hb << 16); wl_[j] = w - wv[j]; }
        hiL[idx] = pack8(wv); loL[idx] = pack8(wl_); }
    __syncthreads();
    const int r16 = lane & 15, q = lane >> 4;
    const int kh = wave >> 2;
    LAS float* xch = (LAS float*)(lds + 65536) + (wave & 3) * 320;
    for (int grp = (wave & 3) * G + bx; grp < NTOK / 16; grp += 4 * G) {
        const float* xr = xsrc + (size_t)(grp * 16 + r16) * DM + 8 * q;
        f32x4m acc = {0.f, 0.f, 0.f, 0.f}; float ss = 0.f;
#pragma unroll 8
        for (int s_ = kh * 16; s_ < kh * 16 + 16; ++s_) {
            const f32x4 x0 = *(const f32x4*)(xr + 32 * s_), x1 = *(const f32x4*)(xr + 32 * s_ + 4);
            float xv[8] = {x0.x, x0.y, x0.z, x0.w, x1.x, x1.y, x1.z, x1.w}, xh[8], xl[8];
#pragma unroll
            for (int j = 0; j < 8; ++j) { ss += xv[j] * xv[j]; }
#pragma unroll
            for (int j = 0; j < 8; j += 2) { const unsigned hp = pk2(xv[j], xv[j + 1]); xh[j] = __uint_as_float(hp << 16); xh[j + 1] = __uint_as_float(hp & 0xffff0000u); xl[j] = xv[j] - xh[j]; xl[j + 1] = xv[j + 1] - xh[j + 1]; }
            { const f32x4 g0 = *(const f32x4*)(g + 32 * s_ + 8 * q), g1 = *(const f32x4*)(g + 32 * s_ + 8 * q + 4);
              const f32x4 o0 = x0 * g0, o1 = x1 * g1; u32x4 w4 = {pk2(o0.x, o0.y), pk2(o0.z, o0.w), pk2(o1.x, o1.y), pk2(o1.z, o1.w)};
              *(u32x4*)(XN + (size_t)(grp * 16 + r16) * DM + 8 * q + 32 * s_) = w4; }
            const bf16x8 ah = pack8(xh), al = pack8(xl);
            const bf16x8 wh = hiL[(s_ * 4 + q) * 16 + r16], wlo = loL[(s_ * 4 + q) * 16 + r16];
            acc = __builtin_amdgcn_mfma_f32_16x16x32_bf16(ah, wh, acc, 0, 0, 0);
            acc = __builtin_amdgcn_mfma_f32_16x16x32_bf16(al, wh, acc, 0, 0, 0);
            acc = __builtin_amdgcn_mfma_f32_16x16x32_bf16(ah, wlo, acc, 0, 0, 0);
        }
        __syncthreads();
        if (kh == 1) { xch[lane] = acc[0]; xch[64 + lane] = acc[1]; xch[128 + lane] = acc[2]; xch[192 + lane] = acc[3]; xch[256 + lane] = ss; }
        __syncthreads();
        if (kh == 0) { acc[0] += xch[lane]; acc[1] += xch[64 + lane]; acc[2] += xch[128 + lane]; acc[3] += xch[192 + lane]; ss += xch[256 + lane]; }
        ss += shx(ss, 16, lane); ss += shx(ss, 32, lane);
        const float rstd = 1.0f / sqrtf(ss * (1.0f / DM) + EPS);
        const float bias = b_if_l[r16];
#pragma unroll
        for (int i = 0; i < 4; ++i) { const float rs = shi(rstd, 4 * q + i); if (kh == 0) GATES[(size_t)r16 * NTOK + grp * 16 + 4 * q + i] = rs * acc[i] + bias; }
        if (kh == 0 && q == 0) RSTD1[grp * 16 + r16] = rstd;
    }
    __syncthreads();
}
DI void phase_rms(int gw, int NGW, int lane, const float* xsrc, const float* g, bf16* XN) {
    f32x4 gg[4];
#pragma unroll
    for (int j = 0; j < 4; ++j) gg[j] = *(const f32x4*)(g + 4 * lane + 256 * j);
    for (int row0 = gw; row0 < NTOK; row0 += 4 * NGW) {
        f32x4 v[4][4];
#pragma unroll
        for (int r = 0; r < 4; ++r) { const int row = row0 + r * NGW; const float* xr = xsrc + (size_t)(row < NTOK ? row : row0) * DM;
#pragma unroll
            for (int j = 0; j < 4; ++j) v[r][j] = *(const f32x4*)(xr + 4 * lane + 256 * j); }
#pragma unroll
        for (int r = 0; r < 4; ++r) { const int row = row0 + r * NGW; float ss = 0.f;
#pragma unroll
            for (int j = 0; j < 4; ++j) ss += (v[r][j].x * v[r][j].x + v[r][j].y * v[r][j].y) + (v[r][j].z * v[r][j].z + v[r][j].w * v[r][j].w);
            ss = wave_sum(ss, lane);
            const float rstd = 1.0f / sqrtf(ss * (1.0f / DM) + EPS);
            if (row < NTOK) {
#pragma unroll
                for (int j = 0; j < 4; ++j) { const f32x4 o = v[r][j] * rstd * gg[j];
                    u32x2 w2 = {pk2(o.x, o.y), pk2(o.z, o.w)}; *(u32x2*)(XN + (size_t)row * DM + 4 * lane + 256 * j) = w2; } }
        }
    }
}

#define CONV_ROWS_LOOP(MASKED, ROWEXPR_STORE) \
    _Pragma("unroll") for (int it = 0; it < NIT; ++it) if (it < nit) { const int row = it * 8 + r8; const int pos = pos0 + row; float o[8]; \
        _Pragma("unroll") for (int j = 0; j < 8; ++j) o[j] = 0.f; \
        _Pragma("unroll") for (int jj = 0; jj < 4; ++jj) { const int p = pos - 3 + jj; const float msk = (MASKED && p < 0) ? 0.f : 1.f;   \
            { const bf16x8 raw = *(const bf16x8*)(col + (size_t)(tb + ((MASKED && p < 0) ? 0 : p)) * PW + oct * 8); const f32x4 wam = MASKED ? wa[jj] * msk : wa[jj], wbm = MASKED ? wb[jj] * msk : wb[jj]; \
                o[0] += wam.x * bf2f(raw[0]); o[1] += wam.y * bf2f(raw[1]); o[2] += wam.z * bf2f(raw[2]); o[3] += wam.w * bf2f(raw[3]); \
                o[4] += wbm.x * bf2f(raw[4]); o[5] += wbm.y * bf2f(raw[5]); o[6] += wbm.z * bf2f(raw[6]); o[7] += wbm.w * bf2f(raw[7]); } } \
        ROWEXPR_STORE }
#define CONV_ROWS_BODY(ROWEXPR_STORE) \
    const int oct = lane & 7, r8 = lane >> 3; \
    f32x4 wa[4], wb[4]; \
    _Pragma("unroll") for (int jj = 0; jj < 4; ++jj) { wa[jj] = *(const f32x4*)(cwp + jj * 1024 + oct * 8); wb[jj] = *(const f32x4*)(cwp + jj * 1024 + oct * 8 + 4); } \
    if (pos0 >= 3) { CONV_ROWS_LOOP(false, ROWEXPR_STORE) } else { CONV_ROWS_LOOP(true, ROWEXPR_STORE) }
template <int NIT> DI void stage_conv_rows(LAS bf16* dst, const bf16* col, const float* cwp, int tb, int pos0, int nit, float scale, int lane) {
    CONV_ROWS_BODY({ _Pragma("unroll") for (int j = 0; j < 8; ++j) o[j] = o[j] * sigm(o[j]) * scale; *(LAS bf16x8*)(dst + row * 72 + oct * 8) = pack8(o); })
}
template <int NIT> DI void stage_conv_rows_t(LAS bf16* dst, const bf16* col, const float* cwp, int tb, int pos0, int nit, float scale, const LAS float* wrow, int lane) {
    CONV_ROWS_BODY({ const float wsc = wrow[row] * scale; _Pragma("unroll") for (int j = 0; j < 8; j += 2) { const unsigned pk = pk2(o[j] * sigm(o[j]) * wsc, o[j + 1] * sigm(o[j + 1]) * wsc);
        dst[(oct * 8 + j) * 72 + row] = (bf16)(pk & 0xffffu); dst[(oct * 8 + j + 1) * 72 + row] = (bf16)(pk >> 16); } })
}

DI void mlstm_a_unit(int u, int hf, int lane, LAS float* scr, const bf16* P, const bf16* VtA, bf16* SL, const float* GATES, float* MLOC, float* BLAST, float* NLOC, const float* cw, float* rk2) {
    asm volatile("" : "+v"(lane));
    LAS bf16* img = (LAS bf16*)(scr + 256);
    const int dvh = u & 1, c = (u >> 1) & 63, bhl = u >> 7;
    const int bl = bhl >> 3, h = bhl & 7, bhg = hf * 16 + bhl;
    const int tb = bl * SEQ, l31 = lane & 31, hi = lane >> 5;
    bf16x8 vf[2][4];
#pragma unroll
    for (int dvb = 0; dvb < 2; ++dvb) {
#pragma unroll
        for (int st = 0; st < 4; ++st) vf[dvb][st] = *(const bf16x8*)(VtA + ((size_t)bhl * 128 + c * 2 + (st >> 1)) * 4096 + ((dvh * 2 + dvb) * 2 + (st & 1)) * 512 + l31 * 16 + hi * 8);
    }
    if (dvh == 0) { float* rp = rk2 + (size_t)bhl * 4096 + c * 64 + lane; *rp = __builtin_amdgcn_rsqf(*rp * (1.0f / 128.f) + EPS); }
    const int gt = hf * HTOK + tb + c * 64 + lane;
    const float fpre = GATES[(size_t)(8 + h) * NTOK + gt], ipre = GATES[(size_t)h * NTOK + gt];
    const float lf = logsigmoid_(fpre);
    const float b = scan_add(lf, lane);
    const float blast = shi(b, 63);
    const float av = blast - b + ipre;
    const float mloc = wave_max(av, lane);
    const float w = expf(av - mloc);
    LDS_FENCE(); scr[lane] = w; LDS_FENCE();
    stage_conv_rows_t<8>(img, P + PC_KA + h * 64, cw + 512 + h * 64, tb, c * 64, 8, 0.125f, scr, lane);
    LDS_FENCE();
#pragma unroll
    for (int dkb = 0; dkb < 2; ++dkb) {
        bf16x8 kwf[4]; float nl = 0.f;
#pragma unroll
        for (int st = 0; st < 4; ++st) { { const s16x4 lo = *(const LAS s16x4*)(img + (dkb * 32 + l31) * 72 + st * 16 + 4 * hi), hh = *(const LAS s16x4*)(img + (dkb * 32 + l31) * 72 + st * 16 + 8 + 4 * hi);
                kwf[st] = (bf16x8){lo[0], lo[1], lo[2], lo[3], hh[0], hh[1], hh[2], hh[3]}; }
#pragma unroll
            for (int j = 0; j < 8; ++j) nl += bf2f(kwf[st][j]); }
        f32x16 acc[2];
#pragma unroll
        for (int a = 0; a < 2; ++a)
#pragma unroll
            for (int r = 0; r < 16; ++r) acc[a][r] = 0.f;
#pragma unroll
        for (int dvb = 0; dvb < 2; ++dvb)
#pragma unroll
            for (int st = 0; st < 4; ++st) acc[dvb] = MFMA32(kwf[st], vf[dvb][st], acc[dvb]);
#pragma unroll
        for (int dvb = 0; dvb < 2; ++dvb) {
            bf16* dst = SL + (size_t)(bhl * 64 + c) * 8192 + (size_t)((dvh * 2 + dvb) * 4 + dkb * 2) * 512 + l31 * 16 + 4 * hi;
#pragma unroll
            for (int g = 0; g < 4; ++g) { u32x2 w2 = {pk2(acc[dvb][4 * g], acc[dvb][4 * g + 1]), pk2(acc[dvb][4 * g + 2], acc[dvb][4 * g + 3])}; *(u32x2*)(dst + (g >> 1) * 512 + (g & 1) * 8) = w2; } }
        if (dvh == 0) { const float n = nl + shx(nl, 32, lane); if (hi == 0) NLOC[(size_t)(bhg * 64 + c) * 64 + dkb * 32 + l31] = n; }
    }
    if (dvh == 0 && lane == 0) { MLOC[bhg * 64 + c] = mloc; BLAST[bhg * 64 + c] = blast; }
    LDS_FENCE();
}

DI void phase_scan(LAS unsigned char* lds, int bx, int G, int tid, int hf, bf16* SL, const float* MLOC, const float* BLAST, float* M0, float* NLOC) {
    LAS float* spL = (LAS float*)lds; LAS float* slL = spL + 64;
    for (int blk = bx; blk < 128; blk += G) {
        const int bhl = blk >> 3, pair = (blk & 7) * 512 + tid, bhg = hf * 16 + bhl;
        unsigned* base = (unsigned*)(SL + (size_t)bhl * 64 * 8192) + pair;
        unsigned v[64];
#pragma unroll
        for (int c = 0; c < 64; ++c) v[c] = base[(size_t)c * 4096];
        __syncthreads();
        if (tid < 64) { const float ml = MLOC[bhg * 64 + tid], bl = BLAST[bhg * 64 + tid];
            const float B = scan_add(bl, tid); const float t = scan_max(ml - B, tid); const float m = B + fmaxf(0.f, t);
            float mprev = shi(m, tid > 0 ? tid - 1 : 0); if (tid == 0) mprev = 0.f;
            spL[tid] = expf(bl + mprev - m); slL[tid] = expf(ml - m);
            if ((blk & 7) == 0) M0[bhg * 64 + tid] = mprev; }
        __syncthreads();
        float s0 = 0.f, s1 = 0.f;
#pragma unroll
        for (int c = 0; c < 64; ++c) {
            const float sp = spL[c], sl = slL[c];
            base[(size_t)c * 4096] = pk2(s0, s1);
            s0 = sp * s0 + sl * __uint_as_float(v[c] << 16); s1 = sp * s1 + sl * __uint_as_float(v[c] & 0xffff0000u);
        }
        if ((blk & 7) == 0 && tid < 64) {
            float* nb = NLOC + (size_t)bhg * 64 * 64 + tid;
            float nv[64];
#pragma unroll
            for (int c = 0; c < 64; ++c) nv[c] = nb[c * 64];
            float n0 = 0.f;
#pragma unroll
            for (int c = 0; c < 64; ++c) { nb[c * 64] = n0; n0 = spL[c] * n0 + slL[c] * nv[c]; }
        }
    }
    __syncthreads();
}

DI void mlstm_c_unit(int u, int hf, int lane, LAS float* scr, const bf16* P, const bf16* VtA, const bf16* SL, const float* GATES, const float* M0, const float* N0,
                     const float* cw, const float* ng, const float* bgate, bf16* Y) {
    asm volatile("" : "+v"(lane));
    LAS bf16* qS = (LAS bf16*)(scr + 256);
    const int th = u & 1, c = (u >> 1) & 63, bhl = u >> 7;
    LAS bf16* kS = (LAS bf16*)(scr - th * 4608 + 256) + 32 * 72;
    const int bl = bhl >> 3, h = bhl & 7, bhg = hf * 16 + bhl;
    const int tb = bl * SEQ, l31 = lane & 31, hi = lane >> 5;
    const int gt = hf * HTOK + tb + c * 64 + lane;
    const float fpre = GATES[(size_t)(8 + h) * NTOK + gt], ipre = GATES[(size_t)h * NTOK + gt];
    f32x4 n0v[4][2];
#pragma unroll
    for (int st = 0; st < 4; ++st) { n0v[st][0] = *(const f32x4*)(N0 + (size_t)(bhg * 64 + c) * 64 + st * 16 + hi * 8); n0v[st][1] = *(const f32x4*)(N0 + (size_t)(bhg * 64 + c) * 64 + st * 16 + hi * 8 + 4); }
    bf16x8 sfr[4][4];
#pragma unroll
    for (int dvb = 0; dvb < 4; ++dvb)
#pragma unroll
        for (int st = 0; st < 4; ++st) sfr[dvb][st] = *(const bf16x8*)(SL + (size_t)(bhl * 64 + c) * 8192 + (size_t)(dvb * 4 + st) * 512 + l31 * 16 + hi * 8);
    const float lf = logsigmoid_(fpre);
    const float b = scan_add(lf, lane);
    const float us = ipre - b;
    const float cm = scan_max(us, lane);
    const float m0 = M0[bhg * 64 + c];
    const float mt = b + fmaxf(m0, cm);
    LDS_FENCE();
    scr[lane] = us; scr[64 + lane] = b - mt; scr[128 + lane] = expf(b + m0 - mt); scr[192 + lane] = expf(-mt);
    stage_conv_rows<4>(qS, P + PC_QA + h * 64, cw + h * 64, tb, c * 64 + th * 32, 4, 1.0f, lane);
    stage_conv_rows<4>(kS + th * 32 * 72, P + PC_KA + h * 64, cw + 512 + h * 64, tb, c * 64 + th * 32, 4, 0.125f, lane);
    LDS_FENCE();
    __syncthreads();
    const int tl = th * 32 + l31;
    const float ct_t = scr[64 + tl], inter_t = scr[128 + tl], emn_t = scr[192 + tl];
    bf16x8 qf[4]; float qn0 = 0.f;
#pragma unroll
    for (int st = 0; st < 4; ++st) { const int dk0 = st * 16 + hi * 8;
        qf[st] = *(const LAS bf16x8*)(qS + l31 * 72 + dk0);
        const f32x4 na = n0v[st][0], nb = n0v[st][1];
        qn0 += bf2f(qf[st][0]) * na.x + bf2f(qf[st][1]) * na.y + bf2f(qf[st][2]) * na.z + bf2f(qf[st][3]) * na.w
             + bf2f(qf[st][4]) * nb.x + bf2f(qf[st][5]) * nb.y + bf2f(qf[st][6]) * nb.z + bf2f(qf[st][7]) * nb.w; }
    f32x16 acc[4];
#pragma unroll
    for (int a = 0; a < 4; ++a)
#pragma unroll
        for (int r = 0; r < 16; ++r) acc[a][r] = 0.f;
#pragma unroll
    for (int dvb = 0; dvb < 4; ++dvb)
#pragma unroll
        for (int st = 0; st < 4; ++st) acc[dvb] = MFMA32(sfr[dvb][st], qf[st], acc[dvb]);
#pragma unroll
    for (int dvb = 0; dvb < 4; ++dvb)
#pragma unroll
        for (int r = 0; r < 16; ++r) acc[dvb][r] *= inter_t;
    asm volatile("" ::: "memory");
    float den = 0.f;
    for (int kb = 0; kb <= th; ++kb) {
        bf16x8 vfr[4][2];
        { const bf16* vb_ = VtA + ((size_t)bhl * 128 + c * 2 + kb) * 4096 + l31 * 16 + hi * 8;
#pragma unroll
          for (int dvb = 0; dvb < 4; ++dvb)
#pragma unroll
            for (int s2 = 0; s2 < 2; ++s2) vfr[dvb][s2] = *(const bf16x8*)(vb_ + (dvb * 2 + s2) * 512); }
        f32x16 s;
#pragma unroll
        for (int r = 0; r < 16; ++r) s[r] = 0.f;
#pragma unroll
        for (int st = 0; st < 4; ++st) { const bf16x8 kf = *(const LAS bf16x8*)(kS + (kb * 32 + l31) * 72 + st * 16 + hi * 8); s = MFMA32(kf, qf[st], s); }
        float pv[16];
#pragma unroll
        for (int g = 0; g < 4; ++g) { const f32x4 u4 = *(const LAS f32x4*)(scr + kb * 32 + 8 * g + 4 * hi);
#pragma unroll
            for (int i = 0; i < 4; ++i) { const int r = 4 * g + i; const int sidx = kb * 32 + 8 * g + 4 * hi + i;
                const float p = (sidx <= tl) ? __expf(ct_t + u4[i]) * s[r] : 0.f; den += p; pv[r] = p; } }
        bf16x8 pf[2]; pf[0] = pack8(pv); pf[1] = pack8(pv + 8);
#pragma unroll
        for (int dvb = 0; dvb < 4; ++dvb)
#pragma unroll
            for (int s2 = 0; s2 < 2; ++s2) acc[dvb] = MFMA32(vfr[dvb][s2], pf[s2], acc[dvb]);
    }
    den += shx(den, 32, lane); qn0 += shx(qn0, 32, lane);
    den += inter_t * qn0;
    const float inv = 1.0f / fmaxf(fabsf(den), emn_t);
    float ss = 0.f;
#pragma unroll
    for (int dvb = 0; dvb < 4; ++dvb)
#pragma unroll
        for (int r = 0; r < 16; ++r) { const float hv = acc[dvb][r] * inv; acc[dvb][r] = hv; ss += hv * hv; }
    ss += shx(ss, 32, lane);
    const float rn = 1.0f / sqrtf(ss * (1.0f / 128.f) + EPS);
    LAS bf16* hL = (LAS bf16*)(scr + 256);
    LDS_FENCE();
    __syncthreads();
#pragma unroll
    for (int dvb = 0; dvb < 4; ++dvb)
#pragma unroll
        for (int g = 0; g < 4; ++g) { u32x2 w2 = {pk2(acc[dvb][4 * g] * rn, acc[dvb][4 * g + 1] * rn), pk2(acc[dvb][4 * g + 2] * rn, acc[dvb][4 * g + 3] * rn)};
            *(LAS u32x2*)(hL + l31 * 136 + dvb * 32 + 8 * g + 4 * hi) = w2; }
    LDS_FENCE();
    const int c16 = lane & 15, r4 = lane >> 4;
    const int ch0 = h * 128 + c16 * 8;
    const f32x4 ng0 = *(const f32x4*)(ng + ch0), ng1 = *(const f32x4*)(ng + ch0 + 4), ba0 = *(const f32x4*)(bgate + ch0), ba1 = *(const f32x4*)(bgate + ch0 + 4),
                bb0 = *(const f32x4*)(bgate + 1024 + ch0), bb1 = *(const f32x4*)(bgate + 1024 + ch0 + 4);
#pragma unroll
    for (int half_ = 0; half_ < 2; ++half_) {
        bf16x8 oa[4], ga[4], gb[4], yb[4];
#pragma unroll
        for (int it = 0; it < 4; ++it) { const int rl = (half_ * 4 + it) * 4 + r4; const bf16* prow = P + (size_t)(tb + c * 64 + th * 32 + rl) * PW + ch0;
            oa[it] = *(const bf16x8*)(prow + PC_OA); ga[it] = *(const bf16x8*)(prow + PC_GA); gb[it] = *(const bf16x8*)(prow + PC_GB); yb[it] = *(const bf16x8*)(prow + PC_QB); }
#pragma unroll
        for (int it = 0; it < 4; ++it) { const int rl = (half_ * 4 + it) * 4 + r4;
            const bf16x8 hv = *(const LAS bf16x8*)(hL + rl * 136 + c16 * 8);
            float o[8];
#pragma unroll
            for (int j = 0; j < 8; ++j) { const float ngj = j < 4 ? ng0[j & 3] : ng1[j & 3], baj = j < 4 ? ba0[j & 3] : ba1[j & 3], bbj = j < 4 ? bb0[j & 3] : bb1[j & 3];
                const float ya = sigm(bf2f(oa[it][j])) * (bf2f(hv[j]) * ngj);
                o[j] = sigm(bf2f(ga[it][j]) + baj) * ya + sigm(bf2f(gb[it][j]) + bbj) * bf2f(yb[it][j]); }
            *(bf16x8*)(Y + (size_t)(hf * HTOK + tb + c * 64 + th * 32 + rl) * DM + ch0) = pack8(o); }
        asm volatile("" ::: "memory");
    }
    LDS_FENCE();
    __syncthreads();
}

DI void sb_unit(int u, int lane, LAS float* scr, bf16* P, const bf16* Kf, const float* rk2, const bf16* VtB, const float* gq, const float* gk, bf16* dummy) {
    asm volatile("" : "+v"(lane));
    const int bhl = u >> 7, qt = u & 127, bl = bhl >> 3, h = bhl & 7;
    const int tb = bl * SEQ, q0 = qt * 32, l31 = lane & 31, hi = lane >> 5;
    LAS bf16x8* qL = (LAS bf16x8*)(scr + 256);
    {
        const int c16 = lane & 15, r4 = lane >> 4;
        LAS float* coefW = scr + 2304;
        LDS_FENCE();
        coefW[lane] = gq[lane] * gk[lane]; coefW[64 + lane] = gq[64 + lane] * gk[64 + lane];
        bf16x8 qraw[8];
#pragma unroll
        for (int it = 0; it < 8; ++it) qraw[it] = *(const bf16x8*)(P + (size_t)(tb + q0 + it * 4 + r4) * PW + PC_QB + h * 128 + c16 * 8);
        LDS_FENCE();
        const f32x4 c0 = *(const LAS f32x4*)(coefW + c16 * 8), c1 = *(const LAS f32x4*)(coefW + c16 * 8 + 4);
#pragma unroll
        for (int it = 0; it < 8; ++it) { float ss = 0.f;
#pragma unroll
            for (int j = 0; j < 8; ++j) { const float v = bf2f(qraw[it][j]); ss += v * v; }
            ss += shx(ss, 1, lane); ss += shx(ss, 2, lane); ss += shx(ss, 4, lane); ss += shx(ss, 8, lane);
            const float rq = (1.0f / sqrtf(ss * (1.0f / 128.f) + EPS)) * (0.08838834764831845f * 1.4426950408889634f);
            float qv[8];
#pragma unroll
            for (int j = 0; j < 8; ++j) qv[j] = bf2f(qraw[it][j]) * rq * (j < 4 ? c0[j & 3] : c1[j & 3]);
            qL[(c16 >> 1) * 64 + (c16 & 1) * 32 + it * 4 + r4] = pack8(qv); }
    }
    LDS_FENCE();
    f32x16 o[4];
#pragma unroll
    for (int a = 0; a < 4; ++a)
#pragma unroll
        for (int r = 0; r < 16; ++r) o[a][r] = 0.f;
    float C = 1.0f;
    const int tq = q0 + l31;
    const bf16* kbase = Kf + (size_t)bhl * 128 * 4096 + l31 * 16 + hi * 8;
    u32x4 kfu[8];
    f32x4 rkq[4];
    const float* rkbase = rk2 + (size_t)bhl * 4096 + 4 * hi;
#define KLOAD(kt_) do { const bf16* kp_ = kbase + (size_t)(kt_) * 4096; _Pragma("unroll") for (int st = 0; st < 8; ++st) asm volatile("global_load_dwordx4 %0, %1, off" : "=v"(kfu[st]) : "v"(kp_ + st * 512)); \
        const float* rp_ = rkbase + (kt_) * 32; _Pragma("unroll") for (int g = 0; g < 4; ++g) asm volatile("global_load_dwordx4 %0, %1, off" : "=v"(rkq[g]) : "v"(rp_ + 8 * g)); } while (0)
#define KWAIT() asm volatile("s_waitcnt vmcnt(0)" : "+v"(kfu[0]), "+v"(kfu[1]), "+v"(kfu[2]), "+v"(kfu[3]), "+v"(kfu[4]), "+v"(kfu[5]), "+v"(kfu[6]), "+v"(kfu[7]), "+v"(rkq[0]), "+v"(rkq[1]), "+v"(rkq[2]), "+v"(rkq[3]) :: "memory")
    KLOAD(qt);
    for (int kt = qt; kt >= 0; --kt) {
        KWAIT();
        bf16x8 kf[8];
#pragma unroll
        for (int st = 0; st < 8; ++st) kf[st] = __builtin_bit_cast(bf16x8, kfu[st]);
        f32x4 rk4[4];
#pragma unroll
        for (int g = 0; g < 4; ++g) { const f32x4 q2 = rkq[g];
#pragma unroll
            for (int i = 0; i < 4; ++i) rk4[g][i] = q2[i]; }
        bf16x8 vfr[4][2];
        { const bf16* vb_ = VtB + ((size_t)bhl * 128 + kt) * 4096 + l31 * 16 + hi * 8;
#pragma unroll
          for (int db = 0; db < 4; ++db)
#pragma unroll
            for (int s2 = 0; s2 < 2; ++s2) vfr[db][s2] = *(const bf16x8*)(vb_ + (db * 2 + s2) * 512); }
        f32x16 s, sB;
#pragma unroll
        for (int r = 0; r < 16; ++r) { s[r] = 0.f; sB[r] = 0.f; }
#pragma unroll
        for (int st = 0; st < 8; st += 2) { s = MFMA32(kf[st], qL[st * 64 + lane], s); sB = MFMA32(kf[st + 1], qL[(st + 1) * 64 + lane], sB); }
#pragma unroll
        for (int r = 0; r < 16; ++r) s[r] += sB[r];
        asm volatile("" ::: "memory");
        KLOAD(kt > 0 ? kt - 1 : 0);
        float btl[16], tot[4], ot[4];
#pragma unroll
        for (int g = 0; g < 4; ++g) { float kp[4], bt[4];
#pragma unroll
            for (int i = 0; i < 4; ++i) { const int r = 4 * g + i; const float e = __builtin_amdgcn_exp2f(s[r] * rk4[g][i]); float k_ = __builtin_amdgcn_rcpf(1.f + e); float b_ = 1.f - k_;
                if (kt == qt) { const int key = kt * 32 + crow(r, hi); if (key >= tq) { k_ = 1.f; b_ = 0.f; } }
                kp[i] = k_; bt[i] = b_; }
            const float s2_ = kp[3], s1_ = s2_ * kp[2], s0_ = s1_ * kp[1];
            btl[4 * g + 3] = bt[3]; btl[4 * g + 2] = bt[2] * s2_; btl[4 * g + 1] = bt[1] * s1_; btl[4 * g] = bt[0] * s0_; tot[g] = s0_ * kp[0]; }
#pragma unroll
        for (int g = 0; g < 4; ++g) ot[g] = shx(tot[g], 32, lane);
        float T[8], suf[8];
#pragma unroll
        for (int g = 0; g < 4; ++g) { T[2 * g] = hi ? ot[g] : tot[g]; T[2 * g + 1] = hi ? tot[g] : ot[g]; }
        suf[7] = 1.f;
#pragma unroll
        for (int G = 6; G >= 0; --G) suf[G] = suf[G + 1] * T[G + 1];
        const float total = suf[0] * T[0];
#pragma unroll
        for (int g = 0; g < 4; ++g) { const float Eg = (hi ? suf[2 * g + 1] : suf[2 * g]) * C;
#pragma unroll
            for (int i = 0; i < 4; ++i) btl[4 * g + i] *= Eg; }
        C *= total;
        bf16x8 pf[2]; pf[0] = pack8(btl); pf[1] = pack8(btl + 8);
#pragma unroll
        for (int db = 0; db < 4; ++db)
#pragma unroll
            for (int s2 = 0; s2 < 2; ++s2) o[db] = MFMA32(vfr[db][s2], pf[s2], o[db]);
        if (__all(C == 0.f)) break;
    }
    KWAIT();
#undef KLOAD
#undef KWAIT
    LAS bf16* oL = (LAS bf16*)(scr + 256);
    LDS_FENCE();
#pragma unroll
    for (int db = 0; db < 4; ++db)
#pragma unroll
        for (int g = 0; g < 4; ++g) { u32x2 w2 = {pk2(o[db][4 * g], o[db][4 * g + 1]), pk2(o[db][4 * g + 2], o[db][4 * g + 3])}; *(LAS u32x2*)(oL + l31 * 136 + db * 32 + 8 * g + 4 * hi) = w2; }
    LDS_FENCE();
    { const int c16 = lane & 15, r4 = lane >> 4;
#pragma unroll
      for (int it = 0; it < 8; ++it) { const int rl = it * 4 + r4; const bf16x8 v = *(const LAS bf16x8*)(oL + rl * 136 + c16 * 8);
          bf16* dst = dummy ? dummy + (size_t)((tb + q0 + rl) & 4095) * 1024 + h * 128 + c16 * 8 : P + (size_t)(tb + q0 + rl) * PW + PC_QB + h * 128 + c16 * 8;
          *(bf16x8*)dst = v; } }
    LDS_FENCE();
}

#define XB_TMO      128
#define XB_XCNT(j)  (256  + 64 * (j))
#define XB_XSUB(j)  (1280 + 64 * (j))
#define XB_XGEN(j)  (2304 + 64 * (j))
#define XB_TOP      3328
#define XB_TOPGEN   3392
#define XCD_BAR_WORDS 3456
#define XB_SPIN_CAP (1u << 18)

__device__ __forceinline__ unsigned xb_ld(unsigned* p)              { return __hip_atomic_load(p, __ATOMIC_RELAXED, __HIP_MEMORY_SCOPE_AGENT); }
__device__ __forceinline__ unsigned xb_add(unsigned* p, unsigned v) { return __hip_atomic_fetch_add(p, v, __ATOMIC_RELAXED, __HIP_MEMORY_SCOPE_AGENT); }
__device__ __forceinline__ unsigned xb_xcc_id() { return (unsigned)__builtin_amdgcn_s_getreg((3 << 11) | 20) & 0xFu; }
#define XB_SPIN(cond, bar) do { unsigned _sp = 0; while (cond) { __builtin_amdgcn_s_sleep(1); \
    if ((++_sp & 255u) == 0u) { if (xb_ld(&(bar)[XB_TMO])) break; if (_sp > XB_SPIN_CAP) { atomicAdd(&(bar)[XB_TMO], 1u); break; } } } } while (0)

struct XcdBarrier {
    unsigned* bar; unsigned x;
    volatile LAS unsigned* st;
};

__device__ __forceinline__ XcdBarrier xcd_barrier_post(unsigned* bar, volatile LAS unsigned* st) {
    XcdBarrier b; b.bar = bar; b.x = xb_xcc_id(); b.st = st;
    if (threadIdx.x == 0) (void)xb_add(&bar[XB_XCNT(b.x)], 1u);
    return b;
}
__device__ __forceinline__ void xcd_barrier_complete(unsigned* bar, unsigned x, unsigned& nloc, unsigned& nx) {
    const unsigned G = gridDim.x * gridDim.y * gridDim.z;
    unsigned sum, cnt, mine, sp = 0u;
    for (;;) {
        sum = 0u; cnt = 0u; mine = 0u;
#pragma unroll
        for (unsigned j = 0; j < 16; ++j) { const unsigned c = xb_ld(&bar[XB_XCNT(j)]); sum += c; cnt += (c > 0u) ? 1u : 0u; mine = (j == x) ? c : mine; }
        if (sum == G) break;
        __builtin_amdgcn_s_sleep(1);
        if ((++sp & 255u) == 0u) { if (xb_ld(&bar[XB_TMO])) break; if (sp > XB_SPIN_CAP) { atomicAdd(&bar[XB_TMO], 1u); break; } }
    }
    nloc = mine > 0u ? mine : 1u; nx = cnt > 0u ? cnt : 1u;
}

__device__ __forceinline__ void xcd_barrier(const XcdBarrier& b) {
    asm volatile("s_waitcnt vmcnt(0)" ::: "memory");
    __syncthreads();
    if (threadIdx.x == 0) {
        unsigned* bar = b.bar;
        __builtin_amdgcn_s_waitcnt(0);
        unsigned nloc = b.st[0], nx = b.st[1];
        if (nloc == 0u) { xcd_barrier_complete(bar, b.x, nloc, nx); b.st[0] = nloc; b.st[1] = nx; }
        const unsigned old = xb_add(&bar[XB_XSUB(b.x)], 1u);
        const unsigned gen = old / nloc;
        if (old + 1u == (gen + 1u) * nloc) {
            __builtin_amdgcn_fence(__ATOMIC_RELEASE, "agent");
            asm volatile("s_waitcnt vmcnt(0)" ::: "memory");
            const unsigned og = xb_add(&bar[XB_TOP], 1u);
            const unsigned tg = og / nx;
            if (og + 1u == (tg + 1u) * nx) xb_add(&bar[XB_TOPGEN], 1u);
            else XB_SPIN(xb_ld(&bar[XB_TOPGEN]) == tg, bar);
            __builtin_amdgcn_fence(__ATOMIC_ACQUIRE, "agent");
            xb_add(&bar[XB_XGEN(b.x)], 1u);
            asm volatile("s_waitcnt vmcnt(0)" ::: "memory");
        } else {
            XB_SPIN(xb_ld(&bar[XB_XGEN(b.x)]) == gen, bar);
            __builtin_amdgcn_fence(__ATOMIC_ACQUIRE, "agent");
            asm volatile("s_waitcnt vmcnt(0)" ::: "memory");
        }
    }
    __syncthreads();
}

#ifndef PROBE_ID
#define PROBE_ID 0
#endif
#define REP_SMALL ((PROBE_ID == 1) ? 2 : 1)
#define REP_RMS ((PROBE_ID == 1 || PROBE_ID == 9) ? 2 : 1)
#define REP_MA ((PROBE_ID == 1 || PROBE_ID == 10) ? 2 : 1)
#define REP_MC ((PROBE_ID == 1 || PROBE_ID == 11) ? 2 : 1)
#define REP_GEMM ((PROBE_ID == 2) ? 2 : 1)
#define REP_SB ((PROBE_ID == 3) ? 2 : 1)
#define REP_SYNC ((PROBE_ID == 4) ? 2 : 1)
struct Args { const float* in[13]; float* out; unsigned char* ws; int ph_lo, ph_hi; };
typedef const volatile __attribute__((address_space(4))) unsigned long long* kargv_t;
DI const float* argp(int i) { kargv_t ka = (kargv_t)__builtin_amdgcn_kernarg_segment_ptr(); return (const float*)(const __attribute__((address_space(1))) float*)ka[i]; }
#define A_IN(i) argp(i)
#define A_OUT ((float*)argp(13))
#define A_WS ((unsigned char*)argp(14))
__global__ void __launch_bounds__(512, 2) fwd_kernel(Args a) {
    extern __shared__ __attribute__((aligned(16))) unsigned char lds_raw[];
    cg::grid_group grid = cg::this_grid();
    LAS unsigned char* lds = (LAS unsigned char*)lds_raw;
    const int G = gridDim.x, NGW = G * 8;
#define PH_BEGIN() int tid = threadIdx.x; asm volatile("" : "+v"(tid)); int bx = blockIdx.x; asm volatile("" : "+s"(bx)); \
    const int lane = tid & 63, wave = __builtin_amdgcn_readfirstlane(tid >> 6), gw = bx * 8 + wave; LAS float* scr = (LAS float*)(lds + wave * 18432); (void)scr; (void)gw; (void)lane
#define XN ((bf16*)(A_WS + WS_XN))
#define Pb ((bf16*)(A_WS + WS_P))
#define VtA ((bf16*)(A_WS + WS_VTA))
#define VtB ((bf16*)(A_WS + WS_VTB))
#define SL ((bf16*)(A_WS + WS_SL))
#define GATES ((float*)(A_WS + WS_GATES))
#define MLOC ((float*)(A_WS + WS_STATS))
#define BLAST (MLOC + 2048)
#define M0 (MLOC + 4096)
#define NLOC (MLOC + 16384)
#define RSQ (MLOC + 200000)
#define RSTD1P (MLOC + 220000)
#define RK2P (MLOC + 240000)
#define xout A_OUT
#define x_in A_IN(0)
#define ws A_WS
    const int lo = a.ph_lo, hi = a.ph_hi;
    int step = 0;
    if (lo < 0) grid.sync();
    if (hi - lo > 1) {
        if (threadIdx.x < 16) ((volatile LAS unsigned*)(lds + 147456))[threadIdx.x] = 0u;
        __syncthreads();
        (void)xcd_barrier_post((unsigned*)A_WS, (volatile LAS unsigned*)(lds + 147456) + 8);
    }
#define GWV() ((G == 256) ? ((((((bx >> 2) & 1) << 7) | (((bx >> 5) & 7) << 4) | ((bx & 3) << 2) | ((bx >> 3) & 3)) << 3) + wave) : gw)
#define RUN() (step >= lo && step < hi)
#define SEAM() do { if (step >= lo && step + 1 < hi) { for (int rs_ = 0; rs_ < REP_SYNC; ++rs_) { XcdBarrier xb_; xb_.bar = (unsigned*)A_WS; xb_.x = xb_xcc_id(); xb_.st = (volatile LAS unsigned*)(lds + 147456) + 8; xcd_barrier(xb_); } } ++step; } while (0)

    if (RUN()) { PH_BEGIN();
        for (int i = bx * 512 + tid; i < 65536; i += G * 512) RK2P[i] = 0.f;
        for (int rp_ = 0; rp_ < ((PROBE_ID == 6) ? 2 : 1); ++rp_) phase_convert(lds, gw, NGW, wave, lane, A_IN(2), A_IN(9), A_IN(11), A_IN(12), ws);
        for (int rp_ = 0; rp_ < REP_RMS; ++rp_) phase_rms_gates(lds, tid, bx, G, wave, lane, x_in, A_IN(1), A_IN(2), A_IN(3), XN, GATES, RSTD1P);
    }
    SEAM();
    for (int l = 0; l < 2; ++l) {
        for (int hf = 0; hf < 2; ++hf) {
            if (RUN()) { PH_BEGIN();
                pg8::Gemm g{XN + (size_t)hf * HTOK * DM, (const bf16*)(ws + WS_WIN) + (size_t)l * 8192 * 1024, HTOK, 8192, DM};
                pg8::StaticOrder S; S.init(HTOK, 8192, G, bx);
                pg8::EpiInProj E{Pb, VtA, VtB, (bf16*)(A_WS + WS_KF), RK2P, RSTD1P + hf * HTOK, lds + 131072};
                for (int rp_ = 0; rp_ < REP_GEMM; ++rp_) pg8::gemm_phase<pg8::EpiInProj, pg8::StaticOrder, true, true>(lds, g, S, E);
            }
            SEAM();
            if (RUN()) { PH_BEGIN();
                for (int rp_ = 0; rp_ < REP_MA; ++rp_) for (int u = GWV(); u < 2048; u += NGW) mlstm_a_unit(u, hf, lane, scr, Pb, VtA, SL, GATES, MLOC, BLAST, NLOC, A_IN(5) + (size_t)l * 4096, RK2P);
            }
            SEAM();
            if (RUN()) { PH_BEGIN();
                phase_scan(lds, bx, G, tid, hf, SL, MLOC, BLAST, M0, NLOC);
                if (hf == 1) for (int i = bx * 512 + tid; i < NTOK; i += G * 512) RSQ[i] = 0.f;
            }
            if (RUN()) { PH_BEGIN();
                for (int rp_ = REP_SB - 1; rp_ >= 0; --rp_) for (int u = GWV(); u < 2048; u += NGW) sb_unit(u, lane, scr, Pb, (const bf16*)(A_WS + WS_KF), RK2P, VtB, A_IN(7) + (size_t)l * 128, A_IN(8) + (size_t)l * 128, rp_ ? (bf16*)(A_WS + WS_END) : (bf16*)nullptr);
            }
            SEAM();
            if (RUN()) { PH_BEGIN();
                for (int i = bx * 512 + tid; i < 65536; i += G * 512) RK2P[i] = 0.f;
                for (int rp_ = 0; rp_ < REP_MC; ++rp_) for (int u = GWV(); u < 2048; u += NGW) mlstm_c_unit(u, hf, lane, scr, Pb, VtA, SL, GATES, M0, NLOC, A_IN(5) + (size_t)l * 4096, A_IN(6) + (size_t)l * 1024, A_IN(4) + (size_t)l * 2048, XN);
            }
            SEAM();
        }
        if (RUN()) { PH_BEGIN();
            pg8::Gemm g{XN, (const bf16*)(ws + WS_WOUT) + (size_t)l * 1024 * 1024, NTOK, DM, DM};
            pg8::StaticOrder S; S.init(NTOK, DM, G, bx);
            const float* xres = (l == 0) ? x_in : (const float*)xout;
            pg8::EpiResNorm E{xres, xout, DM, (bf16*)(A_WS + WS_AN), A_IN(10) + (size_t)l * DM, RSQ};
            pg8::gemm_phase<pg8::EpiResNorm, pg8::StaticOrder, false, true>(lds, g, S, E);
        }
        SEAM();
        if (RUN()) { PH_BEGIN();
            pg8::Gemm g{(const bf16*)(A_WS + WS_AN), (const bf16*)(ws + WS_WUP) + (size_t)l * 4096 * 1024, NTOK, DFF, DM};
            pg8::StaticOrder S; S.init(NTOK, DFF, G, bx);
            pg8::EpiRelu2N E{(bf16*)(A_WS + WS_HID), DFF, RSQ, 1.0f / DM, EPS};
            for (int rp_ = 0; rp_ < REP_GEMM; ++rp_) pg8::gemm_phase<pg8::EpiRelu2N, pg8::StaticOrder, true, true>(lds, g, S, E);
        }
        SEAM();
        if (RUN()) { PH_BEGIN();
            pg8::Gemm g{(const bf16*)(A_WS + WS_HID), (const bf16*)(ws + WS_WDN) + (size_t)l * 1024 * 4096, NTOK, DM, DFF};
            pg8::StaticOrder S; S.init(NTOK, DM, G, bx);
            pg8::EpiRes E{xout, xout, DM};
            pg8::gemm_phase<pg8::EpiRes, pg8::StaticOrder, false, true>(lds, g, S, E);
        }
        SEAM();
        if (l == 0) {
            if (RUN()) { PH_BEGIN(); for (int rp_ = 0; rp_ < REP_RMS; ++rp_) phase_rms_gates(lds, tid, bx, G, wave, lane, xout, A_IN(1) + DM, A_IN(2) + (size_t)DM * INC, A_IN(3) + 16, XN, GATES, RSTD1P); }
            SEAM();
        }
    }
}
#undef XN
#undef Pb
#undef VtA
#undef VtB
#undef SL
#undef GATES
#undef MLOC
#undef BLAST
#undef M0
#undef NLOC
#undef RSQ
#undef RSTD1P
#undef RK2P
#undef xout
#undef x_in
#undef ws
constexpr int N_STEPS = 1 + 2 * (8 + 3) + 1;

#ifndef MK_MULTI
#define MK_MULTI 0
#endif
extern "C" void kernel_launch(void* const* d_in, const int* in_sizes, int n_in, void* d_out, int out_size, void* d_ws, size_t ws_size, hipStream_t stream) {
    static int grid = 0;
    if (grid == 0) {
        if (n_in != 13 || out_size != NTOK * DM || ws_size < WS_TOP) { fprintf(stderr, "kernel_launch: unexpected shapes (n_in %d out %d ws %zu)\n", n_in, out_size, ws_size); grid = -1; return; }
        int dev = 0, cus = 0, per_cu = 0;
        hipGetDevice(&dev);
        hipDeviceGetAttribute(&cus, hipDeviceAttributeMultiprocessorCount, dev);
        if (hipFuncSetAttribute((const void*)fwd_kernel, hipFuncAttributeMaxDynamicSharedMemorySize, LDS_BYTES) != hipSuccess) { fprintf(stderr, "kernel_launch: hipFuncSetAttribute failed\n"); grid = -1; return; }
        if (hipOccupancyMaxActiveBlocksPerMultiprocessor(&per_cu, (const void*)fwd_kernel, 512, LDS_BYTES) != hipSuccess || per_cu < 1) { fprintf(stderr, "kernel_launch: occupancy query says %d\n", per_cu); per_cu = 1; }
        (void)hipGetLastError();
        grid = cus * 1;
        fprintf(stderr, "kernel_launch: grid %d (cus %d, per_cu %d)\n", grid, cus, per_cu);
    }
    if (grid < 0) return;
    if (hipMemsetAsync(d_ws, 0, 16384, stream) != hipSuccess) { fprintf(stderr, "kernel_launch: hipMemsetAsync failed\n"); return; }
    Args a{};
    for (int i = 0; i < 13; ++i) a.in[i] = (const float*)d_in[i];
    a.out = (float*)d_out; a.ws = (unsigned char*)d_ws;
#if MK_MULTI
    for (int s = 0; s < N_STEPS; ++s) { a.ph_lo = s; a.ph_hi = s + 1; hipLaunchKernelGGL(fwd_kernel, dim3(grid), dim3(512), LDS_BYTES, stream, a); }
#else
    a.ph_lo = 0; a.ph_hi = N_STEPS;
    void* args[] = {&a};
    hipError_t e = hipLaunchCooperativeKernel((const void*)fwd_kernel, dim3(grid), dim3(512), args, LDS_BYTES, stream);
    if (e != hipSuccess) fprintf(stderr, "kernel_launch: cooperative launch failed: %s (grid %d)\n", hipGetErrorString(e), grid);
#endif
}
```
